# Optimizing an MI355X kernel written in HIP

```python
import math
import jax
import jax.numpy as jnp
from jax import lax
import numpy as np

D_MODEL = 1024
BATCH = 4
SEQ = 4096
DEPTH = 2

HEAD_DIM = 64
FOX_HEADS = 8
FOX_WIDTH = FOX_HEADS * HEAD_DIM
DIFF_HEADS = 4
DIFF_QK_WIDTH = DIFF_HEADS * 2 * HEAD_DIM
DIFF_V_DIM = 2 * HEAD_DIM
DIFF_WIDTH = DIFF_HEADS * DIFF_V_DIM
CONV_WIDTH = D_MODEL // 2
CONV_K = 3
N_BRANCH = 3
ROPE_THETA = 500000.0
ROT_DIM = HEAD_DIM // 4
Q_BLOCK = 128
RMS_EPS = 1e-6
MAX_POS_OFFSET = 1024
SPLIT_SIZES = (FOX_WIDTH, FOX_WIDTH, FOX_WIDTH, FOX_HEADS, FOX_WIDTH,
               DIFF_QK_WIDTH, DIFF_QK_WIDTH, DIFF_WIDTH, DIFF_WIDTH,
               CONV_WIDTH, CONV_WIDTH, CONV_WIDTH, CONV_WIDTH,
               N_BRANCH * D_MODEL)
IN_WIDTH = (4 * FOX_WIDTH + FOX_HEADS + 2 * DIFF_QK_WIDTH + 2 * DIFF_WIDTH
            + 4 * CONV_WIDTH + N_BRANCH * D_MODEL)

kernel_name = 'hybrid_fox_diffattn_shortconv_gated_merge'


def _rmsnorm(x, g):
    xf = x.astype(jnp.float32)
    y = xf * lax.rsqrt(jnp.mean(xf * xf, axis=-1, keepdims=True) + RMS_EPS)
    return (y * g.astype(jnp.float32)).astype(x.dtype)


def _split_cols(p):
    idx, acc = [], 0
    for s in SPLIT_SIZES[:-1]:
        acc += s
        idx.append(acc)
    return jnp.split(p, idx, axis=-1)


def _rope_tables(positions):
    inv_freq = ROPE_THETA ** (-jnp.arange(0, ROT_DIM, 2, dtype=jnp.float32) / ROT_DIM)
    ang = positions.astype(jnp.float32)[..., None] * inv_freq
    return jnp.cos(ang), jnp.sin(ang)


def _partial_rotary(x, cos, sin):
    half = ROT_DIM // 2
    x1 = x[..., :half].astype(jnp.float32)
    x2 = x[..., half:ROT_DIM].astype(jnp.float32)
    r1 = (x1 * cos - x2 * sin).astype(x.dtype)
    r2 = (x2 * cos + x1 * sin).astype(x.dtype)
    return jnp.concatenate([r1, r2, x[..., ROT_DIM:]], axis=-1)


def _causal_mask(s0, s1):
    q_idx = jnp.arange(s0, s1)[:, None]
    k_idx = jnp.arange(s1)[None, :]
    return k_idx <= q_idx


def _fox_attention(q, k, v, log_f):
    b, s, h, d = q.shape
    q = q.transpose(0, 2, 1, 3)
    k = k.transpose(0, 2, 1, 3)
    v = v.transpose(0, 2, 1, 3)
    c = jnp.cumsum(log_f, axis=1).transpose(0, 2, 1)
    scale = HEAD_DIM ** -0.5
    outs = []
    for s0 in range(0, s, Q_BLOCK):
        s1 = s0 + Q_BLOCK
        logits = jnp.einsum('bhqd,bhkd->bhqk', q[:, :, s0:s1], k[:, :, :s1]).astype(jnp.float32) * scale
        logits = logits + c[:, :, s0:s1, None] - c[:, :, None, :s1]
        p = jax.nn.softmax(jnp.where(_causal_mask(s0, s1), logits, -jnp.inf), axis=-1)
        outs.append(jnp.einsum('bhqk,bhkd->bhqd', p.astype(v.dtype), v[:, :, :s1]))
    o = jnp.concatenate(outs, axis=2)
    return o.transpose(0, 2, 1, 3).reshape(b, s, h * d)


def _diff_attention(q, k, v, lam, lam_init, norm_g):
    b, s, h, _, d = q.shape
    q = q.transpose(0, 2, 3, 1, 4)
    k = k.transpose(0, 2, 3, 1, 4)
    v = v.transpose(0, 2, 1, 3)
    scale = HEAD_DIM ** -0.5
    outs = []
    for s0 in range(0, s, Q_BLOCK):
        s1 = s0 + Q_BLOCK
        logits = jnp.einsum('bhcqd,bhckd->bhcqk', q[:, :, :, s0:s1], k[:, :, :, :s1]).astype(jnp.float32) * scale
        p = jax.nn.softmax(jnp.where(_causal_mask(s0, s1), logits, -jnp.inf), axis=-1)
        a = p[:, :, 0] - lam * p[:, :, 1]
        outs.append(jnp.einsum('bhqk,bhkv->bhqv', a.astype(v.dtype), v[:, :, :s1]))
    o = jnp.concatenate(outs, axis=2)
    o = _rmsnorm(o, norm_g) * (1.0 - lam_init)
    return o.transpose(0, 2, 1, 3).reshape(b, s, h * DIFF_V_DIM)


def _short_conv(u, w):
    rhs = w.astype(u.dtype)[:, None, :]
    return lax.conv_general_dilated(
        u, rhs, window_strides=(1,), padding=[(CONV_K - 1, 0)],
        dimension_numbers=('NWC', 'WIO', 'NWC'), feature_group_count=u.shape[-1])


def _layer(x, cos, sin, layer, pre_g, w_in, b_f, b_m, conv_w, lq1, lk1, lq2, lk2,
           diff_g, w_fox, w_diff, w_conv, w_o, post_g):
    b, s, _ = x.shape
    h = _rmsnorm(x, pre_g)
    p = h @ w_in
    (fq, fk, fv, ff, fg, dq, dk, dv, dg, cb, cc, cx, cg, mg) = _split_cols(p)

    log_f = jax.nn.log_sigmoid((ff + b_f).astype(jnp.float32))
    y_fox = _fox_attention(fq.reshape(b, s, FOX_HEADS, HEAD_DIM),
                           fk.reshape(b, s, FOX_HEADS, HEAD_DIM),
                           fv.reshape(b, s, FOX_HEADS, HEAD_DIM), log_f)
    y_fox = y_fox * jax.nn.silu(fg)

    lam_init = 0.8 - 0.6 * math.exp(-0.3 * layer)
    f32 = jnp.float32
    lam = (jnp.exp(jnp.sum(lq1.astype(f32) * lk1.astype(f32)))
           - jnp.exp(jnp.sum(lq2.astype(f32) * lk2.astype(f32))) + lam_init)
    cs, sn = cos[:, :, None, None, :], sin[:, :, None, None, :]
    q_d = _partial_rotary(dq.reshape(b, s, DIFF_HEADS, 2, HEAD_DIM), cs, sn)
    k_d = _partial_rotary(dk.reshape(b, s, DIFF_HEADS, 2, HEAD_DIM), cs, sn)
    y_diff = _diff_attention(q_d, k_d, dv.reshape(b, s, DIFF_HEADS, DIFF_V_DIM), lam, lam_init, diff_g)
    y_diff = y_diff * jax.nn.silu(dg)

    y_conv = cb * _short_conv(cc * cx, conv_w)
    y_conv = y_conv * jax.nn.silu(cg)

    gates = jax.nn.sigmoid(mg + b_m).reshape(b, s, N_BRANCH, D_MODEL)
    m = (gates[:, :, 0] * (y_fox @ w_fox)
         + gates[:, :, 1] * (y_diff @ w_diff)
         + gates[:, :, 2] * (y_conv @ w_conv))
    o = m @ w_o
    return x + _rmsnorm(o, post_g)


def setup_inputs(seed: int = 0) -> dict:
    key = jax.random.key(seed)
    ks = jax.random.split(key, 20)
    f32 = jnp.float32

    def nrm(k, shape, scale):
        return jax.random.normal(k, shape, f32) * scale

    x = jax.random.normal(ks[0], (BATCH, SEQ, D_MODEL), f32)
    offset = jax.random.randint(ks[1], (BATCH, 1), 0, MAX_POS_OFFSET, dtype=jnp.int32)
    positions = offset + jnp.arange(SEQ, dtype=jnp.int32)[None, :]
    pre_norm_g = 1.0 + nrm(ks[2], (DEPTH, D_MODEL), 0.02)
    w_in = nrm(ks[3], (DEPTH, D_MODEL, IN_WIDTH), D_MODEL ** -0.5)
    b_forget = jax.random.uniform(ks[4], (DEPTH, FOX_HEADS), f32, 1.0, 6.0)
    b_merge = nrm(ks[5], (DEPTH, N_BRANCH * D_MODEL), 0.01)
    conv_w = nrm(ks[6], (DEPTH, CONV_K, CONV_WIDTH), CONV_K ** -0.5)
    lam_q1 = nrm(ks[7], (DEPTH, HEAD_DIM), 0.1)
    lam_k1 = nrm(ks[8], (DEPTH, HEAD_DIM), 0.1)
    lam_q2 = nrm(ks[9], (DEPTH, HEAD_DIM), 0.1)
    lam_k2 = nrm(ks[10], (DEPTH, HEAD_DIM), 0.1)
    diff_norm_g = 1.0 + nrm(ks[11], (DEPTH, DIFF_V_DIM), 0.02)
    w_br_fox = nrm(ks[12], (DEPTH, FOX_WIDTH, D_MODEL), FOX_WIDTH ** -0.5)
    w_br_diff = nrm(ks[13], (DEPTH, DIFF_WIDTH, D_MODEL), DIFF_WIDTH ** -0.5)
    w_br_conv = nrm(ks[14], (DEPTH, CONV_WIDTH, D_MODEL), CONV_WIDTH ** -0.5)
    w_out = nrm(ks[15], (DEPTH, D_MODEL, D_MODEL), D_MODEL ** -0.5)
    post_norm_g = 1.0 + nrm(ks[16], (DEPTH, D_MODEL), 0.02)
    return {'x': x, 'positions': positions, 'pre_norm_g': pre_norm_g, 'w_in': w_in,
            'b_forget': b_forget, 'b_merge': b_merge, 'conv_w': conv_w,
            'lam_q1': lam_q1, 'lam_k1': lam_k1, 'lam_q2': lam_q2, 'lam_k2': lam_k2,
            'diff_norm_g': diff_norm_g, 'w_br_fox': w_br_fox, 'w_br_diff': w_br_diff,
            'w_br_conv': w_br_conv, 'w_out': w_out, 'post_norm_g': post_norm_g}


def reference(x, positions, pre_norm_g, w_in, b_forget, b_merge, conv_w, lam_q1, lam_k1,
              lam_q2, lam_k2, diff_norm_g, w_br_fox, w_br_diff, w_br_conv, w_out, post_norm_g):
    cos, sin = _rope_tables(positions)
    for l in range(DEPTH):
        x = _layer(x, cos, sin, l, pre_norm_g[l], w_in[l], b_forget[l], b_merge[l], conv_w[l],
                   lam_q1[l], lam_k1[l], lam_q2[l], lam_k2[l], diff_norm_g[l],
                   w_br_fox[l], w_br_diff[l], w_br_conv[l], w_out[l], post_norm_g[l])
    return x
```

```cpp
#include <hip/hip_runtime.h>
#include <cstdio>
#include <cstdint>
namespace pg8 {
#define PG8_LAS __attribute__((address_space(3)))
typedef unsigned short bf16_t;
typedef short bf16x8 __attribute__((ext_vector_type(8)));
typedef float f32x4 __attribute__((ext_vector_type(4)));
typedef unsigned u32x4 __attribute__((ext_vector_type(4)));
constexpr int BM = 256, BK = 64, HALF = 128, HTB = HALF * BK * 2  , STAGE_BYTES = 8 * HTB, NXCD = 8, WGM = 8;

__host__ __device__ __forceinline__ int lds_byte(int r, int c) { const int st = (r >> 4) * 2 + (c >> 5), rr = r & 15, cc = c & 31, ob = rr * 64 + cc * 2; return st * 1024 + (ob ^ (((ob >> 9) & 1) << 5)); }
__host__ __device__ __forceinline__ void stage_rc(int b, int& R, int& C) { const int st = b / 1024, sb = b % 1024, swz = sb ^ (((sb >> 9) & 1) << 5); R = (st >> 1) * 16 + swz / 64; C = (st & 1) * 32 + (swz % 64) / 2; }
__host__ __device__ __forceinline__ int perm32(int rho) { const int n = rho >> 4, i = rho & 15; return 8 * (i >> 2) + 4 * n + (i & 3); }

struct Unit { int pm, pn, z; };
struct Gemm { const bf16_t* A; const bf16_t* Bt; int lda, K; size_t Az, Bz; };

struct StaticOrder {
    int nM, nN, nwg, G, c;
    __host__ __device__ void init(int M, int N, int G_, int c_) { nM = M / BM; nN = N / BM; nwg = nM * nN; G = G_; c = c_; }
    __host__ __device__ bool next(int i, Unit& u) const {
        const long L = (long)i * G + c; if (L >= nwg) return false;
        int wgid = (int)L; { const int q = nwg / NXCD, r = nwg % NXCD, xcd = wgid % NXCD, off = wgid / NXCD; wgid = (xcd < r ? xcd * (q + 1) : r * (q + 1) + (xcd - r) * q) + off; }
        const int nig = WGM * nN, gid = wgid / nig, fm = gid * WGM, gsz = (nM - fm) < WGM ? (nM - fm) : WGM;
        u.pm = fm + ((wgid % nig) % gsz); u.pn = (wgid % nig) / gsz; u.z = 0; return true;
    }
    __device__ __forceinline__ void a_ready(const Unit&) const {}
    __device__ __forceinline__ void done(const Unit&) const {}
};

__device__ __forceinline__ unsigned cvt_pk_bf16(float lo, float hi) { unsigned r; asm volatile("v_cvt_pk_bf16_f32 %0, %1, %2" : "=v"(r) : "v"(lo), "v"(hi)); return r; }
typedef float f32x2 __attribute__((ext_vector_type(2)));
constexpr int PW = 6144;
constexpr float QC2 = 0.125f * 1.4426950408889634f;
__device__ __forceinline__ float bf_lo(unsigned w) { return __uint_as_float(w << 16); }
__device__ __forceinline__ float bf_hi(unsigned w) { return __uint_as_float(w & 0xffff0000u); }

struct EpiProj {
    static constexpr bool PERM = true, AFTER_DRAIN = false;
    bf16_t* O; const float* cs;
    __device__ __forceinline__ bool operator()(f32x4 (&acc)[2][2][4][2], const Unit& u, int wr, int wc, int fr, int fq) const {
        const int row0 = u.pm * BM + wr * 64 + fr; const int col0 = u.pn * BM + wc * 32 + 8 * fq; const int pn = u.pn;
        const bool rot = (pn >= 8 && pn < 12) && ((wc & 1) == 0) && (fq < 2);
        const float sc = (pn < 2 || pn == 8 || pn == 9) ? QC2 : 1.f;
#pragma unroll
        for (int ai = 0; ai < 2; ++ai)
#pragma unroll
            for (int m = 0; m < 4; ++m) { const int row = row0 + ai * HALF + m * 16; bf16_t* rowp = O + (size_t)row * PW + col0;
                f32x4 c4 = (f32x4){1.f, 1.f, 1.f, 1.f}, s4 = (f32x4){0.f, 0.f, 0.f, 0.f};
                if (rot) { c4 = *(const f32x4*)(cs + (size_t)row * 16 + 4 * fq); s4 = *(const f32x4*)(cs + (size_t)row * 16 + 8 + 4 * fq); }
#pragma unroll
                for (int bj = 0; bj < 2; ++bj) { f32x4 v0 = acc[ai][bj][m][0], v1 = acc[ai][bj][m][1];
                    if (rot) { f32x4 a, b;
                        a[0] = v0[0] * c4[0] - v0[1] * s4[0]; a[1] = v0[1] * c4[0] + v0[0] * s4[0]; a[2] = v0[2] * c4[1] - v0[3] * s4[1]; a[3] = v0[3] * c4[1] + v0[2] * s4[1];
                        b[0] = v1[0] * c4[2] - v1[1] * s4[2]; b[1] = v1[1] * c4[2] + v1[0] * s4[2]; b[2] = v1[2] * c4[3] - v1[3] * s4[3]; b[3] = v1[3] * c4[3] + v1[2] * s4[3];
                        v0 = a; v1 = b; }
                    v0 = v0 * sc; v1 = v1 * sc; u32x4 w; w.x = cvt_pk_bf16(v0[0], v0[1]); w.y = cvt_pk_bf16(v0[2], v0[3]); w.z = cvt_pk_bf16(v1[0], v1[1]); w.w = cvt_pk_bf16(v1[2], v1[3]);
                    *(u32x4*)(rowp + bj * HALF) = w; }
                asm volatile("" ::: "memory"); }
        return false;
    }
};
struct EpiGate {
    static constexpr bool PERM = true, AFTER_DRAIN = false;
    bf16_t* O; const float* bias;
    __device__ __forceinline__ bool operator()(f32x4 (&acc)[2][2][4][2], const Unit& u, int wr, int wc, int fr, int fq) const {
        const int row0 = u.pm * BM + wr * 64 + fr; const int br = u.pn >> 2;
        const int col0 = 512 + br * 2048 + (u.pn & 3) * BM + wc * 32 + 8 * fq, bcol0 = u.pn * BM + wc * 32 + 8 * fq;
        f32x4 bv[2][2];
#pragma unroll
        for (int bj = 0; bj < 2; ++bj)
#pragma unroll
            for (int n = 0; n < 2; ++n) bv[bj][n] = *(const f32x4*)(bias + bcol0 + bj * HALF + 4 * n);
#pragma unroll
        for (int ai = 0; ai < 2; ++ai)
#pragma unroll
            for (int m = 0; m < 4; ++m) { bf16_t* rowp = O + (size_t)(row0 + ai * HALF + m * 16) * PW + col0;
#pragma unroll
                for (int bj = 0; bj < 2; ++bj) { const f32x4 v0 = acc[ai][bj][m][0] + bv[bj][0], v1 = acc[ai][bj][m][1] + bv[bj][1];
                    u32x4 w; w.x = cvt_pk_bf16(v0[0], v0[1]); w.y = cvt_pk_bf16(v0[2], v0[3]); w.z = cvt_pk_bf16(v1[0], v1[1]); w.w = cvt_pk_bf16(v1[2], v1[3]);
                    *(u32x4*)(rowp + bj * HALF) = w; }
                asm volatile("" ::: "memory"); }
        return false;
    }
};
struct EpiMerge {
    static constexpr bool PERM = true, AFTER_DRAIN = false;
    const bf16_t* Pg; bf16_t* Mo;
    __device__ __forceinline__ bool operator()(f32x4 (&acc)[2][2][4][2], const Unit& u, int wr, int wc, int fr, int fq) const {
        const int row0 = u.pm * BM + wr * 64 + fr; const int br = u.z;
        const int colg = 512 + br * 2048 + u.pn * BM + wc * 32 + 8 * fq, colm = u.pn * BM + wc * 32 + 8 * fq;
        const float L2E = 1.4426950408889634f;
#pragma unroll
        for (int ai = 0; ai < 2; ++ai)
#pragma unroll
            for (int m = 0; m < 4; ++m) { const size_t row = (size_t)(row0 + ai * HALF + m * 16);
#pragma unroll
                for (int bj = 0; bj < 2; ++bj) {
                    const u32x4 ga = *(const u32x4*)(Pg + row * PW + colg + bj * HALF);
                    u32x4 gb = (u32x4){0u, 0u, 0u, 0u}; if (br < 2) gb = *(const u32x4*)(Pg + row * PW + colg + 2048 + bj * HALF);
                    float f[8];
#pragma unroll
                    for (int e = 0; e < 4; ++e) { const unsigned wa = ga[e], wb = gb[e];
                        const float a0 = bf_lo(wa), a1 = bf_hi(wa), b0 = bf_lo(wb), b1 = bf_hi(wb);
                        const float ea0 = __builtin_amdgcn_exp2f(fminf(-a0 * L2E, 100.f)), ea1 = __builtin_amdgcn_exp2f(fminf(-a1 * L2E, 100.f));
                        float n0 = 1.f, n1 = 1.f; if (br < 2) { n0 = 1.f + __builtin_amdgcn_exp2f(fminf(-b0 * L2E, 100.f)); n1 = 1.f + __builtin_amdgcn_exp2f(fminf(-b1 * L2E, 100.f)); }
                        f[2 * e] = n0 * __builtin_amdgcn_rcpf(1.f + ea0); f[2 * e + 1] = n1 * __builtin_amdgcn_rcpf(1.f + ea1); }
                    f32x4 v0 = acc[ai][bj][m][0], v1 = acc[ai][bj][m][1];
                    v0[0] *= f[0]; v0[1] *= f[1]; v0[2] *= f[2]; v0[3] *= f[3]; v1[0] *= f[4]; v1[1] *= f[5]; v1[2] *= f[6]; v1[3] *= f[7];
                    acc[ai][bj][m][0] = v0; acc[ai][bj][m][1] = v1;
                    if (br == 2) { u32x4 w; w.x = cvt_pk_bf16(v0[0], v0[1]); w.y = cvt_pk_bf16(v0[2], v0[3]); w.z = cvt_pk_bf16(v1[0], v1[1]); w.w = cvt_pk_bf16(v1[2], v1[3]);
                        *(u32x4*)(Mo + row * 1024 + colm + bj * HALF) = w; } } }
        return br < 2;
    }
};
struct EpiF32 {
    static constexpr bool PERM = false, AFTER_DRAIN = false;
    float* O;
    __device__ __forceinline__ bool operator()(f32x4 (&acc)[2][2][4][2], const Unit& u, int wr, int wc, int fr, int fq) const {
        const int row0 = u.pm * BM + wr * 64 + fr; const int col0 = u.pn * BM + wc * 32 + 4 * fq;
#pragma unroll
        for (int ai = 0; ai < 2; ++ai)
#pragma unroll
            for (int m = 0; m < 4; ++m) { float* rowp = O + (size_t)(row0 + ai * HALF + m * 16) * 1024 + col0;
#pragma unroll
                for (int bj = 0; bj < 2; ++bj)
#pragma unroll
                    for (int n = 0; n < 2; ++n) *(f32x4*)(rowp + bj * HALF + n * 16) = acc[ai][bj][m][n]; }
        return false;
    }
};
struct MergeOrder {
    StaticOrder so;
    __host__ __device__ void init(int M, int N, int G_, int c_) { so.init(M, N, G_, c_); }
    __host__ __device__ bool next(int i, Unit& u) const { const int j = i / 3; if (!so.next(j, u)) return false; u.z = i - 3 * j; return true; }
    __device__ __forceinline__ void a_ready(const Unit&) const {}
    __device__ __forceinline__ void done(const Unit&) const {}
};


template <class Epi, class Sched, bool ALIGN_EPI = false, bool SP2 = false>
__device__ __forceinline__ void gemm_phase(PG8_LAS unsigned char* lds, const Gemm g, const Sched& S, const Epi& E) {
    int tid_ = threadIdx.x; asm volatile("" : "+v"(tid_));
    const int tid = tid_, wid = __builtin_amdgcn_readfirstlane(tid >> 6), lane = tid & 63, wr = wid >> 2, wc = wid & 3, fr = lane & 15, fq = lane >> 4;
    const int K = g.K, nt = K / BK;
    unsigned voffA[2], voffB[2];
#pragma unroll
    for (int i = 0; i < 2; ++i) { int R, C; stage_rc(tid * 16 + i * 8192, R, C); const int Rb = Epi::PERM ? ((R & ~31) + perm32(R & 31)) : R;
        voffA[i] = (unsigned)(R * g.lda + C) * 2u; voffB[i] = (unsigned)(Rb * K + C) * 2u; }
    const size_t kstep = (size_t)(BK * 2);
    const size_t hstepA = (size_t)HALF * g.lda * 2, hstepB = (size_t)HALF * K * 2;
    const size_t tstepA = 2 * hstepA, tstepB = 2 * hstepB;
    const unsigned ldsw = (unsigned)wid * 1024u;
    const int aoff = lds_byte(wr * 64 + fr, fq * 8), boff = lds_byte(wc * 32 + fr, fq * 8);
#define PG8_SA(b, h) (((b) * 2 + (h)) * HTB)
#define PG8_SB(b, h) ((4 + (b) * 2 + (h)) * HTB)
#define PG8_STAGE(bufoff, gbase, voff) do { _Pragma("unroll") for (int _i = 0; _i < 2; ++_i) \
        __builtin_amdgcn_global_load_lds((const unsigned*)((const char*)(gbase) + (voff)[_i]), (PG8_LAS unsigned*)(lds + (bufoff) + ldsw + _i * 8192), 16, 0, 0); } while (0)
#define PG8_LDA(dst, b, h) do { _Pragma("unroll") for (int m = 0; m < 4; ++m) _Pragma("unroll") for (int k = 0; k < 2; ++k) dst[m][k] = *(const PG8_LAS bf16x8*)(lds + PG8_SA(b, h) + aoff + m * 2048 + k * 1024); } while (0)
#define PG8_LDB(dst, b, h) do { _Pragma("unroll") for (int n = 0; n < 2; ++n) _Pragma("unroll") for (int k = 0; k < 2; ++k) dst[n][k] = *(const PG8_LAS bf16x8*)(lds + PG8_SB(b, h) + boff + n * 2048 + k * 1024); } while (0)
#define PG8_MMA(ai, bj, At, Bt) do { __builtin_amdgcn_s_setprio(1); _Pragma("unroll") for (int m = 0; m < 4; ++m) _Pragma("unroll") for (int n = 0; n < 2; ++n) _Pragma("unroll") for (int k = 0; k < 2; ++k) \
        acc[ai][bj][m][n] = __builtin_amdgcn_mfma_f32_16x16x32_bf16(Bt[n][k], At[m][k], acc[ai][bj][m][n], 0, 0, 0); __builtin_amdgcn_s_setprio(0); } while (0)
#define PG8_WAIT_V(n) asm volatile("s_waitcnt vmcnt(" #n ")" ::: "memory")
#define PG8_WAIT_L(n) asm volatile("s_waitcnt lgkmcnt(" #n ")" ::: "memory")
#define PG8_BAR __builtin_amdgcn_s_barrier()
#define PG8_SCHED __builtin_amdgcn_sched_barrier(0)
    Unit cur, nxt; int ui = 0;
    if (!S.next(0, cur)) return;
    f32x4 acc[2][2][4][2];
#pragma unroll
    for (int a = 0; a < 2; ++a)
#pragma unroll
        for (int b = 0; b < 2; ++b)
#pragma unroll
            for (int m = 0; m < 4; ++m)
#pragma unroll
                for (int n = 0; n < 2; ++n) acc[a][b][m][n] = (f32x4){0.f, 0.f, 0.f, 0.f};
    bf16x8 At[4][2], B0[2][2], B1[2][2];
    const char* cA = (const char*)(g.A + (size_t)cur.z * g.Az) + (size_t)cur.pm * tstepA; const char* cB = (const char*)(g.Bt + (size_t)cur.z * g.Bz) + (size_t)cur.pn * tstepB;
    S.a_ready(cur);
    if constexpr (SP2) {
        PG8_STAGE(PG8_SB(0, 0), cB, voffB); PG8_STAGE(PG8_SB(0, 1), cB + hstepB, voffB); PG8_STAGE(PG8_SA(0, 0), cA, voffA); PG8_STAGE(PG8_SA(0, 1), cA + hstepA, voffA);
        if (wr == 1) PG8_BAR;
        PG8_WAIT_V(2); PG8_BAR;
        PG8_STAGE(PG8_SB(1, 0), cB + kstep, voffB); PG8_STAGE(PG8_SA(1, 0), cA + kstep, voffA); PG8_STAGE(PG8_SB(1, 1), cB + hstepB + kstep, voffB);
        PG8_WAIT_V(6); PG8_BAR;
    } else {
        PG8_STAGE(PG8_SB(0, 0), cB, voffB); PG8_STAGE(PG8_SA(0, 0), cA, voffA); PG8_STAGE(PG8_SB(0, 1), cB + hstepB, voffB); PG8_STAGE(PG8_SA(0, 1), cA + hstepA, voffA);
        if (wr == 1) PG8_BAR;
        PG8_WAIT_V(4); PG8_BAR;
        PG8_STAGE(PG8_SB(1, 0), cB + kstep, voffB); PG8_STAGE(PG8_SA(1, 0), cA + kstep, voffA); PG8_STAGE(PG8_SB(1, 1), cB + hstepB + kstep, voffB);
        PG8_WAIT_V(6); PG8_BAR;
    }
    for (;;) {
        const bool has_next = S.next(ui + 1, nxt);
        const char* nA = has_next ? (const char*)(g.A + (size_t)nxt.z * g.Az) + (size_t)nxt.pm * tstepA : cA; const char* nB = has_next ? (const char*)(g.Bt + (size_t)nxt.z * g.Bz) + (size_t)nxt.pn * tstepB : cB;
        for (int t = 0; t < nt; t += 2) {
            const bool last = (t == nt - 2);
            const char* a1 = cA + (size_t)(t + 1) * kstep;
            const char* a2 = last ? nA : cA + (size_t)(t + 2) * kstep; const char* b2 = last ? nB : cB + (size_t)(t + 2) * kstep;
            const char* a3 = a2 + kstep; const char* b3 = b2 + kstep;
            if (last && has_next) S.a_ready(nxt);
            if constexpr (SP2) {
            PG8_LDB(B0, 0, 0); PG8_LDB(B1, 0, 1); PG8_SCHED; PG8_LDA(At, 0, 0); PG8_STAGE(PG8_SA(1, 1), a1 + hstepA, voffA);
            PG8_WAIT_V(8); PG8_WAIT_L(0); PG8_BAR; PG8_MMA(0, 0, At, B0); PG8_MMA(0, 1, At, B1); PG8_BAR; PG8_SCHED;
            PG8_LDA(At, 0, 1); PG8_STAGE(PG8_SB(0, 0), b2, voffB); PG8_STAGE(PG8_SB(0, 1), b2 + hstepB, voffB); PG8_STAGE(PG8_SA(0, 0), a2, voffA);
            PG8_WAIT_V(8); PG8_WAIT_L(0); PG8_BAR; PG8_MMA(1, 0, At, B0); PG8_MMA(1, 1, At, B1); PG8_BAR; PG8_SCHED;
            PG8_LDB(B0, 1, 0); PG8_LDB(B1, 1, 1); PG8_SCHED; PG8_LDA(At, 1, 0); PG8_STAGE(PG8_SA(0, 1), a2 + hstepA, voffA);
            PG8_WAIT_V(8); PG8_WAIT_L(0); PG8_BAR; PG8_MMA(0, 0, At, B0); PG8_MMA(0, 1, At, B1); PG8_BAR; PG8_SCHED;
            PG8_LDA(At, 1, 1); PG8_STAGE(PG8_SB(1, 0), b3, voffB); PG8_STAGE(PG8_SB(1, 1), b3 + hstepB, voffB); PG8_STAGE(PG8_SA(1, 0), a3, voffA);
            PG8_WAIT_V(8); PG8_WAIT_L(0); PG8_BAR; PG8_MMA(1, 0, At, B0); PG8_MMA(1, 1, At, B1); PG8_BAR; PG8_SCHED;
            } else {
            PG8_LDB(B0, 0, 0); PG8_SCHED; PG8_LDA(At, 0, 0); PG8_STAGE(PG8_SA(1, 1), a1 + hstepA, voffA);
            PG8_WAIT_L(8); PG8_BAR; PG8_WAIT_L(0); PG8_MMA(0, 0, At, B0); PG8_BAR; PG8_SCHED;
            PG8_LDB(B1, 0, 1); PG8_STAGE(PG8_SB(0, 0), b2, voffB);
            PG8_BAR; PG8_WAIT_L(0); PG8_MMA(0, 1, At, B1); PG8_BAR;
            PG8_LDA(At, 0, 1); PG8_STAGE(PG8_SA(0, 0), a2, voffA);
            PG8_BAR; PG8_WAIT_L(0); PG8_MMA(1, 0, At, B0); PG8_BAR; PG8_SCHED;
            PG8_STAGE(PG8_SB(0, 1), b2 + hstepB, voffB);
            PG8_WAIT_V(6); PG8_BAR; PG8_MMA(1, 1, At, B1); PG8_BAR;
            PG8_LDB(B0, 1, 0); PG8_SCHED; PG8_LDA(At, 1, 0); PG8_STAGE(PG8_SA(0, 1), a2 + hstepA, voffA);
            PG8_WAIT_L(8); PG8_BAR; PG8_WAIT_L(0); PG8_MMA(0, 0, At, B0); PG8_BAR; PG8_SCHED;
            PG8_LDB(B1, 1, 1); PG8_STAGE(PG8_SB(1, 0), b3, voffB);
            PG8_BAR; PG8_WAIT_L(0); PG8_MMA(0, 1, At, B1); PG8_BAR;
            PG8_LDA(At, 1, 1); PG8_STAGE(PG8_SA(1, 0), a3, voffA);
            PG8_BAR; PG8_WAIT_L(0); PG8_MMA(1, 0, At, B0); PG8_BAR; PG8_SCHED;
            PG8_STAGE(PG8_SB(1, 1), b3 + hstepB, voffB);
            PG8_WAIT_V(6); PG8_BAR; PG8_MMA(1, 1, At, B1); PG8_BAR;
            }
        }
        if constexpr (ALIGN_EPI) { if (wr == 0) PG8_BAR; }
        bool keep = false; if constexpr (!Epi::AFTER_DRAIN) { keep = E(acc, cur, wr, wc, fr, fq); S.done(cur); }
        if (!has_next) break;
        if (!keep)
#pragma unroll
        for (int a = 0; a < 2; ++a)
#pragma unroll
            for (int b = 0; b < 2; ++b)
#pragma unroll
                for (int m = 0; m < 4; ++m)
#pragma unroll
                    for (int n = 0; n < 2; ++n) acc[a][b][m][n] = (f32x4){0.f, 0.f, 0.f, 0.f};
        cur = nxt; cA = nA; cB = nB; ++ui;
        if constexpr (ALIGN_EPI) { if (wr == 1) PG8_BAR; }
    }
    PG8_WAIT_V(0);
    if constexpr (!ALIGN_EPI) { if (wr == 0) PG8_BAR; }
    PG8_BAR;
    if constexpr (Epi::AFTER_DRAIN) { E.fused(acc, cur, wr, wc, fr, fq, lds, wid, lane); S.done(cur); }
#undef PG8_SA
#undef PG8_SB
#undef PG8_STAGE
#undef PG8_LDA
#undef PG8_LDB
#undef PG8_MMA
#undef PG8_WAIT_V
#undef PG8_WAIT_L
#undef PG8_BAR
#undef PG8_SCHED
}
}

#ifndef PG8_SP2
#define PG8_SP2 true
#endif
#ifndef PG8_ALIGN
#define PG8_ALIGN true
#endif

#include <hip/hip_bf16.h>
#include <cmath>
namespace attn_body {
using bf16=__hip_bfloat16;
using bf16x8=__attribute__((ext_vector_type(8)))short;
using s16x4=__attribute__((ext_vector_type(4)))short;
using f32x16=__attribute__((ext_vector_type(16)))float;
using u32x4=__attribute__((ext_vector_type(4)))unsigned;
using f32x4v=__attribute__((ext_vector_type(4)))float;
constexpr int SEQ=4096,D=64;
constexpr int NW=8,QBLK=32,QB=QBLK*NW,KVBLK=64,NQB=SEQ/QB;
constexpr int ATTN_UNIT_ROWS=QB;
__device__ __forceinline__ int crow(int r,int hi){return (r&3)+8*(r>>2)+4*hi;}
#define SBAR() __builtin_amdgcn_sched_barrier(0)
__device__ __forceinline__ void cmask(f32x16&p0,f32x16&p1,int jb,int qrel,int hi){
  const float NEG=-INFINITY; int kb=64*jb+4*hi;
  #pragma unroll
  for(int r=0;r<16;++r){int kv=kb+(r&3)+8*(r>>2); if(kv>qrel)p0[r]=NEG; if(kv+32>qrel)p1[r]=NEG;}
}

constexpr int NSLOT=3, SLOTB=8192;
constexpr int LDS_K=0, LDS_V=NSLOT*SLOTB, LDS_WS=2*NSLOT*SLOTB, LDS_OST=LDS_WS+NW*64*4, LDS_BIAS=LDS_OST+NW*4096, LDS_BYTES=LDS_BIAS+SEQ*4;
constexpr float C2=0.125f*1.4426950408889634f;
__device__ __forceinline__ void glds16(const void*gsrc,unsigned lds_dst){unsigned keep;
  asm volatile("s_mov_b32 %0, m0\n\ts_mov_b32 m0, %2\n\ts_nop 0\n\tglobal_load_lds_dwordx4 %1, off\n\ts_mov_b32 m0, %0":"=&s"(keep):"v"(gsrc),"s"(lds_dst):"memory");}
__device__ __forceinline__ float max3f(float a,float b,float c){float r;asm("v_max3_f32 %0, %1, %2, %3":"=v"(r):"v"(a),"v"(b),"v"(c));return r;}
__device__ __forceinline__ float max2f(float a,float b){float r;asm("v_max_f32_e32 %0, %1, %2":"=v"(r):"v"(a),"v"(b));return r;}
__device__ __forceinline__ float fadd_s(float a,float b){float r;asm("v_add_f32_e32 %0, %1, %2":"=v"(r):"v"(a),"v"(b));return r;}
__device__ __forceinline__ float fsub_s(float a,float b){float r;asm("v_sub_f32_e32 %0, %1, %2":"=v"(r):"v"(a),"v"(b));return r;}
typedef float f32x2_t __attribute__((ext_vector_type(2))); typedef __bf16 bf16x2_t __attribute__((ext_vector_type(2)));
__device__ __forceinline__ unsigned cvtpk_s(float lo,float hi){f32x2_t v={lo,hi};bf16x2_t b=__builtin_convertvector(v,bf16x2_t);return __builtin_bit_cast(unsigned,b);}
#define WAIT_BAR(N) asm volatile("s_waitcnt vmcnt(" #N ") lgkmcnt(0)\n\ts_barrier":::"memory")

__device__ __forceinline__ void qkt(f32x16&p0,f32x16&p1,const char*Kslot,const bf16x8*qr,int r32,int hi){
  const char*kb=Kslot+hi*1024+r32*16;
  #pragma unroll
  for(int d0=0;d0<4;++d0){
    const bf16x8 b0=*reinterpret_cast<const bf16x8*>(kb+d0*2048);
    const bf16x8 b1=*reinterpret_cast<const bf16x8*>(kb+d0*2048+512);
    {p0=__builtin_amdgcn_mfma_f32_32x32x16_bf16(b0,qr[d0],p0,0,0,0);p1=__builtin_amdgcn_mfma_f32_32x32x16_bf16(b1,qr[d0],p1,0,0,0);}}
}
typedef __attribute__((address_space(3))) const char* lds_cptr;
typedef short v4i16_t __attribute__((ext_vector_type(4)));
__device__ __forceinline__ void kload8(bf16x8*kf,lds_cptr kp){
  kf[0]=*(const __attribute__((address_space(3))) bf16x8*)(kp);      kf[1]=*(const __attribute__((address_space(3))) bf16x8*)(kp+512);
  kf[2]=*(const __attribute__((address_space(3))) bf16x8*)(kp+2048); kf[3]=*(const __attribute__((address_space(3))) bf16x8*)(kp+2560);
  kf[4]=*(const __attribute__((address_space(3))) bf16x8*)(kp+4096); kf[5]=*(const __attribute__((address_space(3))) bf16x8*)(kp+4608);
  kf[6]=*(const __attribute__((address_space(3))) bf16x8*)(kp+6144); kf[7]=*(const __attribute__((address_space(3))) bf16x8*)(kp+6656);
}
__device__ __forceinline__ void kload2(bf16x8*kf,lds_cptr kp,int j){ kf[2*j]=*(const __attribute__((address_space(3))) bf16x8*)(kp+j*2048); kf[2*j+1]=*(const __attribute__((address_space(3))) bf16x8*)(kp+j*2048+512); }
__device__ __forceinline__ s16x4 vtr(lds_cptr p){ return __builtin_bit_cast(s16x4,__builtin_amdgcn_ds_read_tr16_b64_v4i16((__attribute__((address_space(3))) v4i16_t*)p)); }
__device__ __forceinline__ float rowmax(const f32x16&p0,const f32x16&p1){
  float a=max3f(p0[0],p0[1],p1[0]),b=max3f(p0[2],p0[3],p1[1]);a=max3f(a,p1[2],p1[3]);
  #pragma unroll
  for(int r=4;r<16;r+=4){a=max3f(a,p0[r],p0[r+1]);b=max3f(b,p0[r+2],p0[r+3]);a=max3f(a,p1[r],p1[r+1]);b=max3f(b,p1[r+2],p1[r+3]);}
  const float m=max2f(a,b);
  auto rr=__builtin_amdgcn_permlane32_swap(__float_as_uint(m),__float_as_uint(m),false,false);
  return max2f(__uint_as_float(rr[0]),__uint_as_float(rr[1]));
}
__device__ __forceinline__ void pv(f32x16*o,int vb,bf16x8 pa0,bf16x8 pa1,bf16x8 pa2,bf16x8 pa3){
  #pragma unroll
  for(int d0=0;d0<2;++d0){s16x4 lo[4],hi[4];
    #pragma unroll
    for(int ks=0;ks<4;++ks){
      asm volatile("ds_read_b64_tr_b16 %0,%1 offset:%c2":"=&v"(lo[ks]):"v"(vb),"i"(d0*4096+ks*1024):"memory");
      asm volatile("ds_read_b64_tr_b16 %0,%1 offset:%c2":"=&v"(hi[ks]):"v"(vb),"i"(d0*4096+ks*1024+512):"memory");}
    asm volatile("s_waitcnt lgkmcnt(0)":::"memory");SBAR();
    #define PK(k) (bf16x8){lo[k][0],lo[k][1],lo[k][2],lo[k][3],hi[k][0],hi[k][1],hi[k][2],hi[k][3]}
    o[d0]=__builtin_amdgcn_mfma_f32_32x32x16_bf16(pa0,PK(0),o[d0],0,0,0);
    o[d0]=__builtin_amdgcn_mfma_f32_32x32x16_bf16(pa1,PK(1),o[d0],0,0,0);
    o[d0]=__builtin_amdgcn_mfma_f32_32x32x16_bf16(pa2,PK(2),o[d0],0,0,0);
    o[d0]=__builtin_amdgcn_mfma_f32_32x32x16_bf16(pa3,PK(3),o[d0],0,0,0);
    #undef PK
  }
}

#ifndef ATTN_STORE16
#define ATTN_STORE16(p,v) (*(u32x4*)(p)=(v))
#endif
template<int THRL> __device__ __forceinline__ void attn_unit(int qb,const bf16*Qp,const bf16*Kh,const bf16*Vh,bf16*Op,int ldq,int ldo,const float*biasg,char*shm){
  int tid_=threadIdx.x; asm volatile("":"+v"(tid_)); const int tid=tid_,lane=tid&63,r32=lane&31,hi=lane>>5; const int wid=__builtin_amdgcn_readfirstlane(tid>>6);
  const int q0=qb*QB;
  const bf16*Qw=Qp+(long)(q0+wid*QBLK)*ldq;
  const unsigned lds0=(unsigned)(uintptr_t)shm;
  float*wsf=(float*)(shm+LDS_WS)+wid*64;
  const bf16*ksrc=Kh+(long)lane*ldq+wid*8;
  const bf16*vsrc=Vh+(long)(16*(wid&3)+(lane>>2))*ldq+(wid>>2)*32+(lane&3)*8;
  const unsigned kdst=lds0+LDS_K+wid*1024, vdst=lds0+LDS_V+wid*1024;
  #define DMA_K(t,slot) glds16(ksrc+(long)(t)*KVBLK*ldq,(unsigned)__builtin_amdgcn_readfirstlane(kdst+(slot)))
  #define DMA_V(t,slot) glds16(vsrc+(long)(t)*KVBLK*ldq,(unsigned)__builtin_amdgcn_readfirstlane(vdst+(slot)))
  const int vb0=(int)(lds0+LDS_V)+((lane>>4)&1)*32+(lane&3)*8+(4*hi+((lane&15)>>2))*64;
  const char*Kbase=shm+LDS_K; bf16x8 kf[8];
  const lds_cptr shm3=(lds_cptr)shm; const lds_cptr kp0=shm3+LDS_K+hi*1024+r32*16; const lds_cptr vp0=shm3+LDS_V+((lane>>4)&1)*32+(lane&3)*8+(4*hi+((lane&15)>>2))*64;
  const int NT=(q0+QB)/KVBLK;
  { float*bl=(float*)(shm+LDS_BIAS); for(int i=tid;i<q0+QB;i+=NW*64) bl[i]=biasg?biasg[i]:0.f; }
  DMA_K(0,0);DMA_V(0,0);DMA_K(1,SLOTB);
  bf16x8 qr[4];
  #pragma unroll
  for(int d0=0;d0<4;++d0)qr[d0]=*reinterpret_cast<const bf16x8*>(&Qw[(long)r32*ldq+d0*16+hi*8]);
  float mhat=0.f,l_reg=0.f;f32x16 o[2];o[0]=f32x16{};o[1]=f32x16{};
  const int qrel=wid*QBLK+r32;
  const lds_cptr bias3=shm3+LDS_BIAS+hi*16;
  #define BLD(P0,P1,tt) do{ const lds_cptr bp_=bias3+(tt)*256; \
    _Pragma("unroll") for(int g_=0;g_<4;++g_){ const f32x4v x_=*(const __attribute__((address_space(3))) f32x4v*)(bp_+32*g_); const f32x4v y_=*(const __attribute__((address_space(3))) f32x4v*)(bp_+128+32*g_); \
      P0[4*g_]=x_[0];P0[4*g_+1]=x_[1];P0[4*g_+2]=x_[2];P0[4*g_+3]=x_[3]; P1[4*g_]=y_[0];P1[4*g_+1]=y_[1];P1[4*g_+2]=y_[2];P1[4*g_+3]=y_[3]; } }while(0)
  #define BSUB(P0,P1) do{ _Pragma("unroll") for(int r=0;r<16;++r){P0[r]-=mhat;P1[r]-=mhat;} }while(0)
  #define CMASK(P0,P1,t) do{int jb_=(t)-(NT-4); if(jb_>=0)cmask(P0,P1,jb_,qrel,hi);}while(0)
  bool resc=false;
  #define START(P0,P1) do{ const float rm=rowmax(P0,P1); resc=false; \
    { const float dl=rm; mhat=fadd_s(mhat,dl); \
      _Pragma("unroll") for(int r=0;r<16;++r){P0[r]=fsub_s(P0[r],dl);P1[r]=fsub_s(P1[r],dl);} } \
    _Pragma("unroll") for(int r=0;r<16;++r)P0[r]=__builtin_amdgcn_exp2f(P0[r]); }while(0)
  #define RESC() do{ if(resc){ asm volatile("s_waitcnt lgkmcnt(0)":::"memory"); \
      _Pragma("unroll") for(int d_=0;d_<2;++d_) _Pragma("unroll") for(int r=0;r<16;++r)o[d_][r]*=wsf[crow(r,hi)]; } }while(0)
  f32x16 pA0,pA1,pB0,pB1;
  int sl_prev=0,sl_cur=0,sl_next=SLOTB;
  #define ROT() do{sl_prev=sl_cur;sl_cur=sl_next;sl_next=(sl_next==(NSLOT-1)*SLOTB)?0:sl_next+SLOTB;}while(0)
  DMA_K(2,2*SLOTB);
  WAIT_BAR(3);
  BLD(pA0,pA1,0);
  qkt(pA0,pA1,Kbase,qr,r32,hi);asm volatile("s_nop 15\n\ts_nop 7":"+v"(pA0),"+v"(pA1));CMASK(pA0,pA1,0);
  START(pA0,pA1);
  BLD(pB0,pB1,1); BSUB(pB0,pB1);
  _Pragma("unroll") for(int r=0;r<16;++r)pA1[r]=__builtin_amdgcn_exp2f(pA1[r]);
  WAIT_BAR(0);
  DMA_K(3,0);DMA_V(1,SLOTB);
  ROT();
  kload8(kf,kp0+sl_cur);
  WAIT_BAR(2);
  s16x4 vlo[8],vhi[8]; u32x4 pw0,pw1,pw2,pw3;
  #define PKW(P,B) cvtpk_s(P[B],P[B+1])
  #define PAF(k) __builtin_bit_cast(bf16x8,pw##k)
  #define VFR(i) (bf16x8){vlo[i][0],vlo[i][1],vlo[i][2],vlo[i][3],vhi[i][0],vhi[i][1],vhi[i][2],vhi[i][3]}
  #define PIN(x) asm volatile("":"+v"(x))
  #define MX3(a,b,c) __builtin_fmaxf(__builtin_fmaxf((a),(b)),(c))
  #define GAPA(MF,A0,A1,A2,A3,W0,W1,PW) do{ MF; sacc+=A0; sacc+=A1; sacc+=A2; sacc+=A3; PIN(sacc); W0; W1; PIN(PW); SBAR(); }while(0)
  #define EX(v) __builtin_amdgcn_exp2f(v)
  #define GAPB(MF,X,B) do{ MF; X[B]=EX(X[B]); X[B+1]=EX(X[B+1]); X[B+2]=EX(X[B+2]); X[B+3]=EX(X[B+3]); PIN(X); SBAR(); }while(0)
  #define VRD(i) do{ vlo[i]=vtr(vp_+(((i)>>2)*4096+((i)&3)*1024)); vhi[i]=vtr(vp_+(((i)>>2)*4096+((i)&3)*1024+512)); }while(0)
  #define KRD(G,j) do{ if(G){ kload2(kf,kp0+sl_next,j); SBAR(); } }while(0)
  #define STEP(C0,C1,P0,P1,t,GK,GV,GL) do{ SBAR(); \
    const lds_cptr vp_=vp0+sl_prev; \
    VRD(0); SBAR(); float sacc=(P0[0]+P0[1]); \
    GAPA(C0=__builtin_amdgcn_mfma_f32_32x32x16_bf16(kf[0],qr[0],C0,0,0,0), P0[2],P0[3],P0[4],P0[5],     pw0[0]=PKW(P0,0), pw0[1]=PKW(P0,2), pw0); \
    VRD(4); SBAR(); GAPA(C1=__builtin_amdgcn_mfma_f32_32x32x16_bf16(kf[1],qr[0],C1,0,0,0), P0[6],P0[7],P0[8],P0[9],     pw0[2]=PKW(P0,4), pw0[3]=PKW(P0,6), pw0); \
    VRD(1); SBAR(); GAPA(C0=__builtin_amdgcn_mfma_f32_32x32x16_bf16(kf[2],qr[1],C0,0,0,0),   P0[10],P0[11],P0[12],P0[13], pw1[0]=PKW(P0,8), pw1[1]=PKW(P0,10), pw1); \
    VRD(5); SBAR(); GAPA(C1=__builtin_amdgcn_mfma_f32_32x32x16_bf16(kf[3],qr[1],C1,0,0,0),   P0[14],P0[15],P1[0],P1[1],   pw1[2]=PKW(P0,12),pw1[3]=PKW(P0,14), pw1); \
    VRD(2); SBAR(); GAPA(C0=__builtin_amdgcn_mfma_f32_32x32x16_bf16(kf[4],qr[2],C0,0,0,0),   P1[2],P1[3],P1[4],P1[5],     pw2[0]=PKW(P1,0), pw2[1]=PKW(P1,2), pw2); \
    VRD(6); SBAR(); GAPA(C1=__builtin_amdgcn_mfma_f32_32x32x16_bf16(kf[5],qr[2],C1,0,0,0),   P1[6],P1[7],P1[8],P1[9],     pw2[2]=PKW(P1,4), pw2[3]=PKW(P1,6), pw2); \
    VRD(3); SBAR(); GAPA(C0=__builtin_amdgcn_mfma_f32_32x32x16_bf16(kf[6],qr[3],C0,0,0,0),   P1[10],P1[11],P1[12],P1[13], pw3[0]=PKW(P1,8), pw3[1]=PKW(P1,10), pw3); \
    VRD(7); SBAR(); GAPA(C1=__builtin_amdgcn_mfma_f32_32x32x16_bf16(kf[7],qr[3],C1,0,0,0),   P1[14],P1[15],0.f,0.f,       pw3[2]=PKW(P1,12),pw3[3]=PKW(P1,14), pw3); \
    l_reg+=sacc; \
    if(GK){DMA_K((t)+3,sl_cur);} if(GV){DMA_V((t)+1,sl_next);} \
    CMASK(C0,C1,t); \
    { float a=MX3(C0[0],C0[1],C1[0]),b=MX3(C0[2],C0[3],C1[1]); a=MX3(a,C1[2],C1[3]); \
      _Pragma("unroll") for(int r=4;r<16;r+=4){a=MX3(a,C0[r],C0[r+1]);b=MX3(b,C0[r+2],C0[r+3]);a=MX3(a,C1[r],C1[r+1]);b=MX3(b,C1[r+2],C1[r+3]);} \
      float rm=__builtin_fmaxf(a,b); { auto rr=__builtin_amdgcn_permlane32_swap(__float_as_uint(rm),__float_as_uint(rm),false,false); rm=__builtin_fmaxf(__uint_as_float(rr[0]),__uint_as_float(rr[1])); } \
      resc=false; \
      if(__builtin_expect(__any(rm>(float)THRL),0)){ const float dl=__builtin_fmaxf(rm,0.f); mhat+=dl; \
        _Pragma("unroll") for(int r=0;r<16;++r){C0[r]-=dl;C1[r]-=dl;} \
        const float f=__builtin_amdgcn_exp2f(-dl); l_reg*=f; if(hi==0)wsf[r32]=f; resc=true; } } \
    SBAR(); \
    if(GL){ BLD(P0,P1,(t)+1); SBAR(); } \
    GAPB(o[0]=__builtin_amdgcn_mfma_f32_32x32x16_bf16(PAF(0),VFR(0),o[0],0,0,0), C0,0); \
    GAPB(o[1]=__builtin_amdgcn_mfma_f32_32x32x16_bf16(PAF(0),VFR(4),o[1],0,0,0), C0,4); \
    KRD(GL,0); GAPB(o[0]=__builtin_amdgcn_mfma_f32_32x32x16_bf16(PAF(1),VFR(1),o[0],0,0,0), C0,8); \
    KRD(GL,1); GAPB(o[1]=__builtin_amdgcn_mfma_f32_32x32x16_bf16(PAF(1),VFR(5),o[1],0,0,0), C0,12); \
    KRD(GL,2); GAPB(o[0]=__builtin_amdgcn_mfma_f32_32x32x16_bf16(PAF(2),VFR(2),o[0],0,0,0), C1,0); \
    KRD(GL,3); GAPB(o[1]=__builtin_amdgcn_mfma_f32_32x32x16_bf16(PAF(2),VFR(6),o[1],0,0,0), C1,4); \
    GAPB(o[0]=__builtin_amdgcn_mfma_f32_32x32x16_bf16(PAF(3),VFR(3),o[0],0,0,0), C1,8); \
    GAPB(o[1]=__builtin_amdgcn_mfma_f32_32x32x16_bf16(PAF(3),VFR(7),o[1],0,0,0), C1,12); \
    if(GL){ BSUB(P0,P1); } \
    }while(0)
  int t=1;
  #undef CMASK
  #define CMASK(P0,P1,t) do{}while(0)
  for(;t+5<NT;t+=2){
    STEP(pB0,pB1,pA0,pA1,t,true,true,true);     WAIT_BAR(2); RESC(); ROT();
    STEP(pA0,pA1,pB0,pB1,t+1,true,true,true);   WAIT_BAR(2); RESC(); ROT();
  }
  #undef CMASK
  #define CMASK(P0,P1,t) do{int jb_=(t)-(NT-4); if(jb_>=0)cmask(P0,P1,jb_,qrel,hi);}while(0)
  #define ENDW(tt) do{ if((tt)+3<NT){WAIT_BAR(2);} else if((tt)+2<NT){WAIT_BAR(1);} else {WAIT_BAR(0);} }while(0)
  for(;t+1<NT;t+=2){
    STEP(pB0,pB1,pA0,pA1,t,(t+3<NT),(t+1<NT),(t+1<NT));       ENDW(t);   RESC(); ROT();
    STEP(pA0,pA1,pB0,pB1,t+1,(t+4<NT),(t+2<NT),(t+2<NT));     ENDW(t+1); RESC(); ROT();
  }
  STEP(pB0,pB1,pA0,pA1,NT-1,false,false,false); RESC();
  { float sacc=pB0[0]+pB0[1]; _Pragma("unroll") for(int r=2;r<16;++r)sacc+=pB0[r]; _Pragma("unroll") for(int r=0;r<16;++r)sacc+=pB1[r]; l_reg+=sacc;
    pw0=(u32x4){PKW(pB0,0),PKW(pB0,2),PKW(pB0,4),PKW(pB0,6)};pw1=(u32x4){PKW(pB0,8),PKW(pB0,10),PKW(pB0,12),PKW(pB0,14)};pw2=(u32x4){PKW(pB1,0),PKW(pB1,2),PKW(pB1,4),PKW(pB1,6)};pw3=(u32x4){PKW(pB1,8),PKW(pB1,10),PKW(pB1,12),PKW(pB1,14)};
    SBAR(); pv(o,vb0+sl_cur,PAF(0),PAF(1),PAF(2),PAF(3)); }
  #undef PKW
  #undef PAF
  #undef VFR
  #undef PIN
  #undef MX3
  #undef GAPA
  #undef GAPB
  #undef EX
  #undef VRD
  #undef KRD
  #undef STEP
  #undef ENDW
  {auto rr=__builtin_amdgcn_permlane32_swap(__float_as_uint(l_reg),__float_as_uint(l_reg),false,false);l_reg=__uint_as_float(rr[0])+__uint_as_float(rr[1]);}
  if(hi==0)wsf[32+r32]=l_reg;asm volatile("s_waitcnt lgkmcnt(0)":::"memory");
  float rli[16];
  #pragma unroll
  for(int r=0;r<16;++r)rli[r]=__builtin_amdgcn_rcpf(wsf[32+crow(r,hi)]);
  bf16*Ow=Op+(long)(q0+wid*QBLK)*ldo;
  { bf16*stg=(bf16*)(shm+LDS_OST)+wid*2048;
    #pragma unroll
    for(int r=0;r<16;++r){const int orow=crow(r,hi);
      #pragma unroll
      for(int d0=0;d0<2;++d0)stg[orow*64+d0*32+r32]=__float2bfloat16(o[d0][r]*rli[r]);}
    asm volatile("s_waitcnt lgkmcnt(0)":::"memory");
    #pragma unroll
    for(int i=0;i<4;++i){const int row=i*8+(lane>>3),ch=lane&7; const u32x4 v=*(const u32x4*)(stg+row*64+ch*8); ATTN_STORE16(Ow+(long)row*ldo+ch*8,v);} }
  asm volatile("s_waitcnt lgkmcnt(0)\n\ts_barrier":::"memory");
  #undef BLD
  #undef BSUB
  #undef DMA_K
  #undef DMA_V
  #undef CMASK
  #undef START
  #undef RESC
  #undef ROT
}
constexpr int ATTN_LDS_BYTES=LDS_BYTES;
#undef SBAR
#undef WAIT_BAR
}


#include <hip/hip_cooperative_groups.h>
namespace cg = cooperative_groups;
#define LAS __attribute__((address_space(3)))
typedef unsigned short bf16r;
typedef unsigned v4u __attribute__((ext_vector_type(4)));
typedef float f32x4 __attribute__((ext_vector_type(4)));

constexpr int NWAVES = 8, NTHR = 512;
constexpr int NB = 4, SEQ = 4096, DM = 1024, T = NB * SEQ, DEPTH = 2, INW = 9224, PW = pg8::PW, NMG = 3072;
constexpr float RMS_EPS = 1e-6f;
constexpr size_t MiB = 1u << 20;
constexpr size_t WS_LOGF = 0;
constexpr size_t WS_CNEG = 512 * 1024;
constexpr size_t WS_CS = 1 * MiB;
constexpr size_t WS_W1 = 4 * MiB;
constexpr size_t WS_WMG = 16 * MiB;
constexpr size_t WS_WBR = 22 * MiB;
constexpr size_t WS_WO = 25 * MiB;
constexpr size_t WS_H = 28 * MiB;
constexpr size_t WS_OD = 60 * MiB;
constexpr size_t WS_P = 92 * MiB;
constexpr size_t WS_END = 284 * MiB;
constexpr int LDS_BYTES = 131072;
#ifndef PHM
#define PHM 127
#endif

__device__ __forceinline__ unsigned pk2(float lo, float hi) { return pg8::cvt_pk_bf16(lo, hi); }
__device__ __forceinline__ float wave_sum(float v) {
#pragma unroll
    for (int o = 1; o < 64; o <<= 1) v += __shfl_xor(v, o);
    return v;
}
__device__ __forceinline__ float silu_f(float v) { return v * __builtin_amdgcn_rcpf(1.f + __builtin_amdgcn_exp2f(fminf(-v * 1.4426950408889634f, 100.f))); }

template <int MODE> __device__ __forceinline__ int cmap(int n) {
    if (MODE == 1) {
        int o = n + (n >= 1536 ? 8 : 0);
        if (n >= 2048 && n < 3072) { const int w = n & 63; if (w < 16) o = (n & ~63) + 8 + ((w & 1) ? 8 + (w >> 1) : (w >> 1)); }
        return o;
    }
    if (MODE == 2) return 6152 + n;
    return n;
}
template <int MODE> __device__ __forceinline__ void transpose_item(const float* W, int ldw, int K, int N, bf16r* WT, LAS float* scr, int item, int lane) {
    const int nblk = N / 32, kb = item / nblk, nb = item % nblk, k0 = 64 * kb, n0 = 32 * nb;
    const int oc = cmap<MODE>(n0 + (lane & 31));
#pragma unroll 8
    for (int i = 0; i < 32; ++i) { const int kk = 2 * i + (lane >> 5); scr[kk * 33 + (lane & 31)] = W[(size_t)(k0 + kk) * ldw + oc]; }
    asm volatile("s_waitcnt lgkmcnt(0)" ::: "memory");
    const int c = lane & 7;
#pragma unroll
    for (int j = 0; j < 4; ++j) { const int n = (lane >> 3) + 8 * j; const LAS float* s = scr + (8 * c) * 33 + n;
        v4u o; o.x = pk2(s[0 * 33], s[1 * 33]); o.y = pk2(s[2 * 33], s[3 * 33]); o.z = pk2(s[4 * 33], s[5 * 33]); o.w = pk2(s[6 * 33], s[7 * 33]);
        *(v4u*)(WT + (size_t)(n0 + n) * K + k0 + 8 * c) = o; }
    asm volatile("s_waitcnt lgkmcnt(0)" ::: "memory");
}

struct Args { const void* in[17]; float* out; unsigned char* ws; };

__global__ void __launch_bounds__(NTHR, 2) fwd_megakernel(Args a) {
    extern __shared__ __attribute__((aligned(16))) unsigned char lds[];
    cg::grid_group grid = cg::this_grid();
    LAS unsigned char* ldsl = (LAS unsigned char*)lds;
    const int G = gridDim.x, bx = blockIdx.x;
    const int vcu = (G % 8 == 0) ? (bx % 8) * (G / 8) + bx / 8 : bx;
    const int NGW = G * NWAVES;
    unsigned char* ws = a.ws;
    const float* x_in = (const float*)a.in[0]; const int* positions = (const int*)a.in[1];
    float* LOGF = (float*)(ws + WS_LOGF); float* CNEG = (float*)(ws + WS_CNEG); float* CS = (float*)(ws + WS_CS);
    bf16r* W1t = (bf16r*)(ws + WS_W1); bf16r* Wmgt = (bf16r*)(ws + WS_WMG); bf16r* Wbrt = (bf16r*)(ws + WS_WBR); bf16r* Wot = (bf16r*)(ws + WS_WO);
    bf16r* H = (bf16r*)(ws + WS_H); bf16r* OD = (bf16r*)(ws + WS_OD); bf16r* P = (bf16r*)(ws + WS_P); float* O32 = (float*)(ws + WS_P);
    float* out = a.out;
#define GSYNC() do { __threadfence(); grid.sync(); __threadfence(); } while (0)

#pragma unroll 1
    for (int l = 0; l <= DEPTH; ++l) {
        const bool fin = (l == DEPTH);
        int tid = threadIdx.x; asm volatile("" : "+v"(tid)); const int lane = tid & 63, wave = __builtin_amdgcn_readfirstlane(tid >> 6), gw = bx * NWAVES + wave;
        if (!fin && (PHM & 1)) {
            LAS float* scr = (LAS float*)(ldsl + 32768 + wave * 8704);
            const float* win = (const float*)a.in[3] + (size_t)l * DM * INW;
            const float* wbf = (const float*)a.in[12] + (size_t)l * 512 * DM; const float* wbd = (const float*)a.in[13] + (size_t)l * 512 * DM;
            const float* wbc = (const float*)a.in[14] + (size_t)l * 512 * DM; const float* wo = (const float*)a.in[15] + (size_t)l * DM * DM;
            constexpr int I_1 = 16 * 192, I_G = 16 * 96, I_B = 8 * 32, I_O = 16 * 32, NITEMS = I_1 + I_G + 3 * I_B + I_O;
            for (int it = gw; it < NITEMS; it += NGW) {
                int r = it;
                if (r < I_1) { transpose_item<1>(win, INW, DM, PW, W1t, scr, r, lane); continue; } r -= I_1;
                if (r < I_G) { transpose_item<2>(win, INW, DM, NMG, Wmgt, scr, r, lane); continue; } r -= I_G;
                if (r < I_B) { transpose_item<0>(wbf, DM, 512, DM, Wbrt, scr, r, lane); continue; } r -= I_B;
                if (r < I_B) { transpose_item<0>(wbd, DM, 512, DM, Wbrt + 512 * DM, scr, r, lane); continue; } r -= I_B;
                if (r < I_B) { transpose_item<0>(wbc, DM, 512, DM, Wbrt + 2 * 512 * DM, scr, r, lane); continue; } r -= I_B;
                transpose_item<0>(wo, DM, DM, DM, Wot, scr, r, lane);
            }
        }
        if (PHM & 2) {
            LAS float* wff = (LAS float*)ldsl;
            if (!fin) { const float* win = (const float*)a.in[3] + (size_t)l * DM * INW;
                for (int i = tid; i < 8192; i += NTHR) { const int k = i >> 3, hh = i & 7; wff[hh * 1024 + k] = win[(size_t)k * INW + 1536 + hh]; } }
            __syncthreads();
            const float* xin = (l <= 1) ? x_in : out;
            const f32x4* postg = (const f32x4*)((const float*)a.in[16] + (size_t)(l > 0 ? l - 1 : 0) * DM);
            const f32x4* preg = (const f32x4*)((const float*)a.in[2] + (size_t)(fin ? 0 : l) * DM);
            const float* bfg = (const float*)a.in[4] + (fin ? 0 : l) * 8;
            for (int row = gw; row < T; row += NGW) {
                const f32x4* xr = (const f32x4*)(xin + (size_t)row * DM) + lane;
                f32x4 v[4];
#pragma unroll
                for (int j = 0; j < 4; ++j) v[j] = xr[64 * j];
                if (l > 0) {
                    const f32x4* orw = (const f32x4*)(O32 + (size_t)row * DM) + lane; f32x4 ov[4]; float ss = 0.f;
#pragma unroll
                    for (int j = 0; j < 4; ++j) { ov[j] = orw[64 * j]; ss += (ov[j].x * ov[j].x + ov[j].y * ov[j].y) + (ov[j].z * ov[j].z + ov[j].w * ov[j].w); }
                    const float rs = rsqrtf(wave_sum(ss) * (1.f / DM) + RMS_EPS);
                    f32x4* xo = (f32x4*)(out + (size_t)row * DM) + lane;
#pragma unroll
                    for (int j = 0; j < 4; ++j) { v[j] = v[j] + ov[j] * rs * postg[lane + 64 * j]; xo[64 * j] = v[j]; }
                }
                if (!fin) {
                    float ss = 0.f;
#pragma unroll
                    for (int j = 0; j < 4; ++j) ss += (v[j].x * v[j].x + v[j].y * v[j].y) + (v[j].z * v[j].z + v[j].w * v[j].w);
                    const float rs = rsqrtf(wave_sum(ss) * (1.f / DM) + RMS_EPS);
                    unsigned long long* o8 = (unsigned long long*)(H + (size_t)row * DM) + lane;
#pragma unroll
                    for (int j = 0; j < 4; ++j) { v[j] = v[j] * rs * preg[lane + 64 * j];
                        o8[64 * j] = (unsigned long long)pk2(v[j].x, v[j].y) | ((unsigned long long)pk2(v[j].z, v[j].w) << 32); }
                    float d[8];
#pragma unroll
                    for (int hh = 0; hh < 8; ++hh) { float s = 0.f;
#pragma unroll
                        for (int j = 0; j < 4; ++j) { const f32x4 w = *(const LAS f32x4*)(wff + hh * 1024 + 4 * lane + 256 * j); s += (v[j].x * w.x + v[j].y * w.y) + (v[j].z * w.z + v[j].w * w.w); }
                        d[hh] = wave_sum(s); }
                    if (lane < 8) {
                        float z = d[0];
#pragma unroll
                        for (int hh = 1; hh < 8; ++hh) z = (lane == hh) ? d[hh] : z;
                        z += bfg[lane];
                        LOGF[(size_t)row * 8 + lane] = fminf(z, 0.f) - log1pf(expf(-fabsf(z)));
                    } else if (l == 0 && lane < 16) {
                        const int i = lane - 8;
                        float invf = 1.0f;
                        invf = (i == 1) ? 0.19392274f : invf; invf = (i == 2) ? 0.03760603f : invf; invf = (i == 3) ? 0.0072926646f : invf; invf = (i == 4) ? 0.0014142136f : invf;
                        invf = (i == 5) ? 0.0002742482f : invf; invf = (i == 6) ? 5.3182957e-05f : invf; invf = (i == 7) ? 1.0313385e-05f : invf;
                        const float ang = (float)positions[row] * invf;
                        const float n = rintf(ang * 0.15915494309189535f);
                        float r = fmaf(-n, 6.2831854820251465f, ang); r = fmaf(-n, -1.7484555e-7f, r);
                        CS[(size_t)row * 16 + i] = __cosf(r); CS[(size_t)row * 16 + 8 + i] = __sinf(r);
                    }
                }
            }
        }
        if (fin) break;
        GSYNC();
        if (PHM & 4) {
            LAS float* sc = (LAS float*)ldsl;
            for (int bh = bx; bh < NB * 8; bh += G) {
                const int b = bh >> 3, hh = bh & 7; const int t0 = tid * 8;
                float v[8]; float run = 0.f;
#pragma unroll
                for (int e = 0; e < 8; ++e) { run += LOGF[((size_t)b * SEQ + t0 + e) * 8 + hh]; v[e] = run; }
                float incl = run;
#pragma unroll
                for (int o = 1; o < 64; o <<= 1) { const float n = __shfl_up(incl, o); if (lane >= o) incl += n; }
                if (lane == 63) sc[wave] = incl;
                __syncthreads();
                float base = incl - run;
                for (int w = 0; w < wave; ++w) base += sc[w];
                float* cn = CNEG + (size_t)bh * SEQ + t0;
#pragma unroll
                for (int e = 0; e < 8; ++e) cn[e] = -(base + v[e]) * 1.4426950408889634f;
                __syncthreads();
            }
            pg8::Gemm g{H, W1t, DM, DM, 0, 0}; pg8::StaticOrder S; S.init(T, PW, G, bx);
            pg8::EpiProj E{P, CS};
            pg8::gemm_phase<pg8::EpiProj, pg8::StaticOrder, true, true>(ldsl, g, S, E);
        }
        GSYNC();
        if (PHM & 8) {
            const float* cw = (const float*)a.in[6] + (size_t)l * 3 * 512;
            for (int it = bx * NTHR + tid; it < T * 64; it += G * NTHR) {
                const int t = it >> 6, c8 = (it & 63) * 8, s = t & (SEQ - 1);
                bf16r* pr = P + (size_t)t * PW;
                const v4u cb = *(const v4u*)(pr + 4096 + c8), cg_ = *(const v4u*)(pr + 5632 + c8);
                const v4u zero = (v4u){0u, 0u, 0u, 0u};
                const v4u c0 = *(const v4u*)(pr + 4608 + c8), x0 = *(const v4u*)(pr + 5120 + c8);
                const v4u c1 = s >= 1 ? *(const v4u*)(pr - PW + 4608 + c8) : zero, x1 = s >= 1 ? *(const v4u*)(pr - PW + 5120 + c8) : zero;
                const v4u c2 = s >= 2 ? *(const v4u*)(pr - 2 * PW + 4608 + c8) : zero, x2 = s >= 2 ? *(const v4u*)(pr - 2 * PW + 5120 + c8) : zero;
                float k0[8], k1[8], k2[8];
#pragma unroll
                for (int q = 0; q < 2; ++q) { const f32x4 wa = *(const f32x4*)(cw + c8 + 4 * q), wb = *(const f32x4*)(cw + 512 + c8 + 4 * q), wc_ = *(const f32x4*)(cw + 1024 + c8 + 4 * q);
                    k0[4 * q] = wa.x; k0[4 * q + 1] = wa.y; k0[4 * q + 2] = wa.z; k0[4 * q + 3] = wa.w; k1[4 * q] = wb.x; k1[4 * q + 1] = wb.y; k1[4 * q + 2] = wb.z; k1[4 * q + 3] = wb.w;
                    k2[4 * q] = wc_.x; k2[4 * q + 1] = wc_.y; k2[4 * q + 2] = wc_.z; k2[4 * q + 3] = wc_.w; }
                v4u o;
#pragma unroll
                for (int e = 0; e < 4; ++e) {
                    const float ul0 = pg8::bf_lo(c0[e]) * pg8::bf_lo(x0[e]), uh0 = pg8::bf_hi(c0[e]) * pg8::bf_hi(x0[e]);
                    const float ul1 = pg8::bf_lo(c1[e]) * pg8::bf_lo(x1[e]), uh1 = pg8::bf_hi(c1[e]) * pg8::bf_hi(x1[e]);
                    const float ul2 = pg8::bf_lo(c2[e]) * pg8::bf_lo(x2[e]), uh2 = pg8::bf_hi(c2[e]) * pg8::bf_hi(x2[e]);
                    const float yl = pg8::bf_lo(cb[e]) * (k0[2 * e] * ul2 + k1[2 * e] * ul1 + k2[2 * e] * ul0) * silu_f(pg8::bf_lo(cg_[e]));
                    const float yh = pg8::bf_hi(cb[e]) * (k0[2 * e + 1] * uh2 + k1[2 * e + 1] * uh1 + k2[2 * e + 1] * uh0) * silu_f(pg8::bf_hi(cg_[e]));
                    o[e] = pk2(yl, yh);
                }
                *(v4u*)(pr + 4096 + c8) = o;
            }
            asm volatile("s_waitcnt vmcnt(0)" ::: "memory"); __syncthreads();
            const int NPAIR = NB * 24 * 8, PPW = (NPAIR + G - 1) / G;
            for (int pi = vcu * PPW; pi < (vcu + 1) * PPW && pi < NPAIR; ++pi) {
                const int bhu = pi >> 3, s = pi & 7, b = bhu / 24, u = bhu % 24;
                const attn_body::bf16* Pb = (const attn_body::bf16*)(P + (size_t)b * SEQ * PW);
                const attn_body::bf16 *Qp, *Kp, *Vp; attn_body::bf16* Op; int ldo; const float* bias;
                if (u < 8) { Qp = Pb + u * 64; Kp = Pb + 512 + u * 64; Vp = Pb + 1024 + u * 64; Op = (attn_body::bf16*)Qp; ldo = PW; bias = CNEG + (size_t)(b * 8 + u) * SEQ; }
                else { const int d = u - 8, h = d >> 2, c = (d >> 1) & 1, vh = d & 1;
                    Qp = Pb + 2048 + h * 128 + c * 64; Kp = Pb + 2560 + h * 128 + c * 64; Vp = Pb + 3072 + h * 128 + vh * 64;
                    Op = (attn_body::bf16*)(OD + (size_t)b * SEQ * DM) + c * 512 + h * 128 + vh * 64; ldo = DM; bias = nullptr; }
#pragma unroll 1
                for (int k = 0; k < 2; ++k) attn_body::attn_unit<8>(k ? 15 - s : s, Qp, Kp, Vp, Op, PW, ldo, bias, (char*)lds);
            }
        }
        GSYNC();
        if (PHM & 16) {
            for (int it = bx * NTHR + tid; it < T * 64; it += G * NTHR) {
                const int t = it >> 6, c8 = (it & 63) * 8; bf16r* pr = P + (size_t)t * PW;
                const v4u ov = *(const v4u*)(pr + c8), gv = *(const v4u*)(pr + 1536 + c8); v4u o;
#pragma unroll
                for (int e = 0; e < 4; ++e) o[e] = pk2(pg8::bf_lo(ov[e]) * silu_f(pg8::bf_lo(gv[e])), pg8::bf_hi(ov[e]) * silu_f(pg8::bf_hi(gv[e])));
                *(v4u*)(pr + c8) = o;
            }
            const float lam_init = 0.8f - 0.6f * expf(-0.3f * (float)l);
            const float p1 = ((const float*)a.in[7])[l * 64 + lane] * ((const float*)a.in[8])[l * 64 + lane], p2 = ((const float*)a.in[9])[l * 64 + lane] * ((const float*)a.in[10])[l * 64 + lane];
            const float lam = expf(wave_sum(p1)) - expf(wave_sum(p2)) + lam_init;
            const float* dgn = (const float*)a.in[11] + (size_t)l * 128;
            const int j0 = (lane & 15) * 8;
            const f32x4 ga = *(const f32x4*)(dgn + j0), gb = *(const f32x4*)(dgn + j0 + 4); const float gg[8] = {ga.x, ga.y, ga.z, ga.w, gb.x, gb.y, gb.z, gb.w};
            for (int it = gw; it < T; it += NGW) {
                const int t = it, h = lane >> 4; bf16r* pr = P + (size_t)t * PW; const bf16r* od = OD + (size_t)t * DM;
                const v4u o0 = *(const v4u*)(od + h * 128 + j0), o1 = *(const v4u*)(od + 512 + h * 128 + j0), dg = *(const v4u*)(pr + 3584 + h * 128 + j0);
                float dv[8]; float ss = 0.f;
#pragma unroll
                for (int e = 0; e < 4; ++e) { dv[2 * e] = pg8::bf_lo(o0[e]) - lam * pg8::bf_lo(o1[e]); dv[2 * e + 1] = pg8::bf_hi(o0[e]) - lam * pg8::bf_hi(o1[e]); ss += dv[2 * e] * dv[2 * e] + dv[2 * e + 1] * dv[2 * e + 1]; }
                ss += __shfl_xor(ss, 1); ss += __shfl_xor(ss, 2); ss += __shfl_xor(ss, 4); ss += __shfl_xor(ss, 8);
                const float rs = rsqrtf(ss * (1.f / 128.f) + RMS_EPS) * (1.f - lam_init);
                v4u o;
#pragma unroll
                for (int e = 0; e < 4; ++e) { const float g0 = gg[2 * e], g1 = gg[2 * e + 1];
                    o[e] = pk2(dv[2 * e] * rs * g0 * silu_f(pg8::bf_lo(dg[e])), dv[2 * e + 1] * rs * g1 * silu_f(pg8::bf_hi(dg[e]))); }
                *(v4u*)(pr + 2048 + h * 128 + j0) = o;
            }
            asm volatile("s_waitcnt vmcnt(0)" ::: "memory"); __syncthreads();
            pg8::Gemm g{H, Wmgt, DM, DM, 0, 0}; pg8::StaticOrder S; S.init(T, NMG, G, bx);
            pg8::EpiGate E{P, (const float*)a.in[5] + (size_t)l * NMG};
            pg8::gemm_phase<pg8::EpiGate, pg8::StaticOrder, true, true>(ldsl, g, S, E);
        }
        GSYNC();
        if (PHM & 32) {
            pg8::Gemm g{P, Wbrt, PW, 512, 2048, (size_t)512 * DM}; pg8::MergeOrder S; S.init(T, DM, G, bx);
            pg8::EpiMerge E{P, H};
            pg8::gemm_phase<pg8::EpiMerge, pg8::MergeOrder, true, true>(ldsl, g, S, E);
        }
        GSYNC();
        if (PHM & 64) {
            pg8::Gemm g{H, Wot, DM, DM, 0, 0}; pg8::StaticOrder S; S.init(T, DM, G, bx);
            pg8::EpiF32 E{O32};
            pg8::gemm_phase<pg8::EpiF32, pg8::StaticOrder, true, true>(ldsl, g, S, E);
        }
        GSYNC();
    }
#undef GSYNC
}

extern "C" void kernel_launch(void* const* d_in, const int* in_sizes, int n_in, void* d_out, int out_size, void* d_ws, size_t ws_size, hipStream_t stream) {
    static int grid = 0;
    if (grid == 0) {
        if (n_in != 17 || out_size != T * DM || ws_size < WS_END) { fprintf(stderr, "kernel_launch: unexpected shapes / workspace (n_in %d, out %d, ws %zu < %zu)\n", n_in, out_size, ws_size, (size_t)WS_END); grid = -1; return; }
        int dev = 0, cus = 0, per_cu = 0;
        hipGetDevice(&dev); hipDeviceGetAttribute(&cus, hipDeviceAttributeMultiprocessorCount, dev);
        hipFuncSetAttribute((const void*)fwd_megakernel, hipFuncAttributeMaxDynamicSharedMemorySize, LDS_BYTES);
        if (hipOccupancyMaxActiveBlocksPerMultiprocessor(&per_cu, (const void*)fwd_megakernel, NTHR, LDS_BYTES) != hipSuccess || per_cu < 1) per_cu = 1;
        (void)hipGetLastError();
        grid = cus * per_cu;
    }
    if (grid < 0) return;
    Args a{};
    for (int i = 0; i < 17; ++i) a.in[i] = d_in[i];
    a.out = (float*)d_out; a.ws = (unsigned char*)d_ws;
    void* args[] = {&a};
    hipError_t e = hipLaunchCooperativeKernel((const void*)fwd_megakernel, dim3(grid), dim3(NTHR), args, LDS_BYTES, stream);
    if (e != hipSuccess) fprintf(stderr, "cooperative launch failed: %s (grid %d)\n", hipGetErrorString(e), grid);
}
```

```cpp
#include <hip/hip_runtime.h>
#include <cstdio>
#include <cstdint>
namespace pg8 {
#define PG8_LAS __attribute__((address_space(3)))
typedef unsigned short bf16_t;
typedef short bf16x8 __attribute__((ext_vector_type(8)));
typedef float f32x4 __attribute__((ext_vector_type(4)));
typedef unsigned u32x4 __attribute__((ext_vector_type(4)));
constexpr int BM = 256, BK = 64, HALF = 128, HTB = HALF * BK * 2  , STAGE_BYTES = 8 * HTB, NXCD = 8, WGM = 8;

__host__ __device__ __forceinline__ int lds_byte(int r, int c) { const int st = (r >> 4) * 2 + (c >> 5), rr = r & 15, cc = c & 31, ob = rr * 64 + cc * 2; return st * 1024 + (ob ^ (((ob >> 9) & 1) << 5)); }
__host__ __device__ __forceinline__ void stage_rc(int b, int& R, int& C) { const int st = b / 1024, sb = b % 1024, swz = sb ^ (((sb >> 9) & 1) << 5); R = (st >> 1) * 16 + swz / 64; C = (st & 1) * 32 + (swz % 64) / 2; }
__host__ __device__ __forceinline__ int perm32(int rho) { const int n = rho >> 4, i = rho & 15; return 8 * (i >> 2) + 4 * n + (i & 3); }

struct Unit { int pm, pn, z; };
struct Gemm { const bf16_t* A; const bf16_t* Bt; int lda, K; size_t Az, Bz; };

struct StaticOrder {
    int nM, nN, nwg, G, c;
    __host__ __device__ void init(int M, int N, int G_, int c_) { nM = M / BM; nN = N / BM; nwg = nM * nN; G = G_; c = c_; }
    __host__ __device__ bool next(int i, Unit& u) const {
        const long L = (long)i * G + c; if (L >= nwg) return false;
        int wgid = (int)L; { const int q = nwg / NXCD, r = nwg % NXCD, xcd = wgid % NXCD, off = wgid / NXCD; wgid = (xcd < r ? xcd * (q + 1) : r * (q + 1) + (xcd - r) * q) + off; }
        const int nig = WGM * nN, gid = wgid / nig, fm = gid * WGM, gsz = (nM - fm) < WGM ? (nM - fm) : WGM;
        u.pm = fm + ((wgid % nig) % gsz); u.pn = (wgid % nig) / gsz; u.z = 0; return true;
    }
    __device__ __forceinline__ void a_ready(const Unit&) const {}
    __device__ __forceinline__ void done(const Unit&) const {}
};

__device__ __forceinline__ unsigned cvt_pk_bf16(float lo, float hi) { unsigned r; asm volatile("v_cvt_pk_bf16_f32 %0, %1, %2" : "=v"(r) : "v"(lo), "v"(hi)); return r; }
typedef float f32x2 __attribute__((ext_vector_type(2)));
constexpr int PW = 6144;
constexpr float QC2 = 0.125f * 1.4426950408889634f;
__device__ __forceinline__ float bf_lo(unsigned w) { return __uint_as_float(w << 16); }
__device__ __forceinline__ float bf_hi(unsigned w) { return __uint_as_float(w & 0xffff0000u); }

struct EpiProj {
    static constexpr bool PERM = true, AFTER_DRAIN = false;
    bf16_t* O; const float* cs;
    __device__ __forceinline__ bool operator()(f32x4 (&acc)[2][2][4][2], const Unit& u, int wr, int wc, int fr, int fq) const {
        const int row0 = u.pm * BM + wr * 64 + fr; const int col0 = u.pn * BM + wc * 32 + 8 * fq; const int pn = u.pn;
        const bool rot = (pn >= 8 && pn < 12) && ((wc & 1) == 0) && (fq < 2);
        const float sc = (pn < 2 || pn == 8 || pn == 9) ? QC2 : 1.f;
#pragma unroll
        for (int ai = 0; ai < 2; ++ai)
#pragma unroll
            for (int m = 0; m < 4; ++m) { const int row = row0 + ai * HALF + m * 16; bf16_t* rowp = O + (size_t)row * PW + col0;
                f32x4 c4 = (f32x4){1.f, 1.f, 1.f, 1.f}, s4 = (f32x4){0.f, 0.f, 0.f, 0.f};
                if (rot) { c4 = *(const f32x4*)(cs + (size_t)row * 16 + 4 * fq); s4 = *(const f32x4*)(cs + (size_t)row * 16 + 8 + 4 * fq); }
#pragma unroll
                for (int bj = 0; bj < 2; ++bj) { f32x4 v0 = acc[ai][bj][m][0], v1 = acc[ai][bj][m][1];
                    if (rot) { f32x4 a, b;
                        a[0] = v0[0] * c4[0] - v0[1] * s4[0]; a[1] = v0[1] * c4[0] + v0[0] * s4[0]; a[2] = v0[2] * c4[1] - v0[3] * s4[1]; a[3] = v0[3] * c4[1] + v0[2] * s4[1];
                        b[0] = v1[0] * c4[2] - v1[1] * s4[2]; b[1] = v1[1] * c4[2] + v1[0] * s4[2]; b[2] = v1[2] * c4[3] - v1[3] * s4[3]; b[3] = v1[3] * c4[3] + v1[2] * s4[3];
                        v0 = a; v1 = b; }
                    v0 = v0 * sc; v1 = v1 * sc; u32x4 w; w.x = cvt_pk_bf16(v0[0], v0[1]); w.y = cvt_pk_bf16(v0[2], v0[3]); w.z = cvt_pk_bf16(v1[0], v1[1]); w.w = cvt_pk_bf16(v1[2], v1[3]);
                    *(u32x4*)(rowp + bj * HALF) = w; }
                asm volatile("" ::: "memory"); }
        return false;
    }
};
struct EpiGate {
    static constexpr bool PERM = true, AFTER_DRAIN = false;
    bf16_t* O; const float* bias;
    __device__ __forceinline__ bool operator()(f32x4 (&acc)[2][2][4][2], const Unit& u, int wr, int wc, int fr, int fq) const {
        const int row0 = u.pm * BM + wr * 64 + fr; const int br = u.pn >> 2;
        const int col0 = 512 + br * 2048 + (u.pn & 3) * BM + wc * 32 + 8 * fq, bcol0 = u.pn * BM + wc * 32 + 8 * fq;
        f32x4 bv[2][2];
#pragma unroll
        for (int bj = 0; bj < 2; ++bj)
#pragma unroll
            for (int n = 0; n < 2; ++n) bv[bj][n] = *(const f32x4*)(bias + bcol0 + bj * HALF + 4 * n);
#pragma unroll
        for (int ai = 0; ai < 2; ++ai)
#pragma unroll
            for (int m = 0; m < 4; ++m) { bf16_t* rowp = O + (size_t)(row0 + ai * HALF + m * 16) * PW + col0;
#pragma unroll
                for (int bj = 0; bj < 2; ++bj) { const f32x4 v0 = acc[ai][bj][m][0] + bv[bj][0], v1 = acc[ai][bj][m][1] + bv[bj][1];
                    u32x4 w; w.x = cvt_pk_bf16(v0[0], v0[1]); w.y = cvt_pk_bf16(v0[2], v0[3]); w.z = cvt_pk_bf16(v1[0], v1[1]); w.w = cvt_pk_bf16(v1[2], v1[3]);
                    *(u32x4*)(rowp + bj * HALF) = w; }
                asm volatile("" ::: "memory"); }
        return false;
    }
};
struct EpiMerge {
    static constexpr bool PERM = true, AFTER_DRAIN = false;
    const bf16_t* Pg; bf16_t* Mo;
    __device__ __forceinline__ bool operator()(f32x4 (&acc)[2][2][4][2], const Unit& u, int wr, int wc, int fr, int fq) const {
        const int row0 = u.pm * BM + wr * 64 + fr; const int br = u.z;
        const int colg = 512 + br * 2048 + u.pn * BM + wc * 32 + 8 * fq, colm = u.pn * BM + wc * 32 + 8 * fq;
        const float L2E = 1.4426950408889634f;
#pragma unroll
        for (int ai = 0; ai < 2; ++ai)
#pragma unroll
            for (int m = 0; m < 4; ++m) { const size_t row = (size_t)(row0 + ai * HALF + m * 16);
#pragma unroll
                for (int bj = 0; bj < 2; ++bj) {
                    const u32x4 ga = *(const u32x4*)(Pg + row * PW + colg + bj * HALF);
                    u32x4 gb = (u32x4){0u, 0u, 0u, 0u}; if (br < 2) gb = *(const u32x4*)(Pg + row * PW + colg + 2048 + bj * HALF);
                    float f[8];
#pragma unroll
                    for (int e = 0; e < 4; ++e) { const unsigned wa = ga[e], wb = gb[e];
                        const float a0 = bf_lo(wa), a1 = bf_hi(wa), b0 = bf_lo(wb), b1 = bf_hi(wb);
                        const float ea0 = __builtin_amdgcn_exp2f(fminf(-a0 * L2E, 100.f)), ea1 = __builtin_amdgcn_exp2f(fminf(-a1 * L2E, 100.f));
                        float n0 = 1.f, n1 = 1.f; if (br < 2) { n0 = 1.f + __builtin_amdgcn_exp2f(fminf(-b0 * L2E, 100.f)); n1 = 1.f + __builtin_amdgcn_exp2f(fminf(-b1 * L2E, 100.f)); }
                        f[2 * e] = n0 * __builtin_amdgcn_rcpf(1.f + ea0); f[2 * e + 1] = n1 * __builtin_amdgcn_rcpf(1.f + ea1); }
                    f32x4 v0 = acc[ai][bj][m][0], v1 = acc[ai][bj][m][1];
                    v0[0] *= f[0]; v0[1] *= f[1]; v0[2] *= f[2]; v0[3] *= f[3]; v1[0] *= f[4]; v1[1] *= f[5]; v1[2] *= f[6]; v1[3] *= f[7];
                    acc[ai][bj][m][0] = v0; acc[ai][bj][m][1] = v1;
                    if (br == 2) { u32x4 w; w.x = cvt_pk_bf16(v0[0], v0[1]); w.y = cvt_pk_bf16(v0[2], v0[3]); w.z = cvt_pk_bf16(v1[0], v1[1]); w.w = cvt_pk_bf16(v1[2], v1[3]);
                        *(u32x4*)(Mo + row * 1024 + colm + bj * HALF) = w; } } }
        return br < 2;
    }
};
struct EpiF32 {
    static constexpr bool PERM = true, AFTER_DRAIN = false;
    bf16_t* O;
    __device__ __forceinline__ bool operator()(f32x4 (&acc)[2][2][4][2], const Unit& u, int wr, int wc, int fr, int fq) const {
        const int row0 = u.pm * BM + wr * 64 + fr; const int col0 = u.pn * BM + wc * 32 + 8 * fq;
#pragma unroll
        for (int ai = 0; ai < 2; ++ai)
#pragma unroll
            for (int m = 0; m < 4; ++m) { bf16_t* rowp = O + (size_t)(row0 + ai * HALF + m * 16) * 1024 + col0;
#pragma unroll
                for (int bj = 0; bj < 2; ++bj) { const f32x4 v0 = acc[ai][bj][m][0], v1 = acc[ai][bj][m][1];
                    u32x4 w; w.x = cvt_pk_bf16(v0[0], v0[1]); w.y = cvt_pk_bf16(v0[2], v0[3]); w.z = cvt_pk_bf16(v1[0], v1[1]); w.w = cvt_pk_bf16(v1[2], v1[3]);
                    *(u32x4*)(rowp + bj * HALF) = w; } }
        return false;
    }
};
struct MergeOrder {
    StaticOrder so;
    __host__ __device__ void init(int M, int N, int G_, int c_) { so.init(M, N, G_, c_); }
    __host__ __device__ bool next(int i, Unit& u) const { const int j = i / 3; if (!so.next(j, u)) return false; u.z = i - 3 * j; return true; }
    __device__ __forceinline__ void a_ready(const Unit&) const {}
    __device__ __forceinline__ void done(const Unit&) const {}
};


template <class Epi, class Sched, bool ALIGN_EPI = false, bool SP2 = false>
__device__ __forceinline__ void gemm_phase(PG8_LAS unsigned char* lds, const Gemm g, const Sched& S, const Epi& E) {
    int tid_ = threadIdx.x; asm volatile("" : "+v"(tid_));
    const int tid = tid_, wid = __builtin_amdgcn_readfirstlane(tid >> 6), lane = tid & 63, wr = wid >> 2, wc = wid & 3, fr = lane & 15, fq = lane >> 4;
    const int K = g.K, nt = K / BK;
    unsigned voffA[2], voffB[2];
#pragma unroll
    for (int i = 0; i < 2; ++i) { int R, C; stage_rc(tid * 16 + i * 8192, R, C); const int Rb = Epi::PERM ? ((R & ~31) + perm32(R & 31)) : R;
        voffA[i] = (unsigned)(R * g.lda + C) * 2u; voffB[i] = (unsigned)(Rb * K + C) * 2u; }
    const size_t kstep = (size_t)(BK * 2);
    const size_t hstepA = (size_t)HALF * g.lda * 2, hstepB = (size_t)HALF * K * 2;
    const size_t tstepA = 2 * hstepA, tstepB = 2 * hstepB;
    const unsigned ldsw = (unsigned)wid * 1024u;
    const int aoff = lds_byte(wr * 64 + fr, fq * 8), boff = lds_byte(wc * 32 + fr, fq * 8);
#define PG8_SA(b, h) (((b) * 2 + (h)) * HTB)
#define PG8_SB(b, h) ((4 + (b) * 2 + (h)) * HTB)
#define PG8_STAGE(bufoff, gbase, voff) do { _Pragma("unroll") for (int _i = 0; _i < 2; ++_i) \
        __builtin_amdgcn_global_load_lds((const unsigned*)((const char*)(gbase) + (voff)[_i]), (PG8_LAS unsigned*)(lds + (bufoff) + ldsw + _i * 8192), 16, 0, 0); } while (0)
#define PG8_LDA(dst, b, h) do { _Pragma("unroll") for (int m = 0; m < 4; ++m) _Pragma("unroll") for (int k = 0; k < 2; ++k) dst[m][k] = *(const PG8_LAS bf16x8*)(lds + PG8_SA(b, h) + aoff + m * 2048 + k * 1024); } while (0)
#define PG8_LDB(dst, b, h) do { _Pragma("unroll") for (int n = 0; n < 2; ++n) _Pragma("unroll") for (int k = 0; k < 2; ++k) dst[n][k] = *(const PG8_LAS bf16x8*)(lds + PG8_SB(b, h) + boff + n * 2048 + k * 1024); } while (0)
#define PG8_MMA(ai, bj, At, Bt) do { __builtin_amdgcn_s_setprio(1); _Pragma("unroll") for (int m = 0; m < 4; ++m) _Pragma("unroll") for (int n = 0; n < 2; ++n) _Pragma("unroll") for (int k = 0; k < 2; ++k) \
        acc[ai][bj][m][n] = __builtin_amdgcn_mfma_f32_16x16x32_bf16(Bt[n][k], At[m][k], acc[ai][bj][m][n], 0, 0, 0); __builtin_amdgcn_s_setprio(0); } while (0)
#define PG8_WAIT_V(n) asm volatile("s_waitcnt vmcnt(" #n ")" ::: "memory")
#define PG8_WAIT_L(n) asm volatile("s_waitcnt lgkmcnt(" #n ")" ::: "memory")
#define PG8_BAR __builtin_amdgcn_s_barrier()
#define PG8_SCHED __builtin_amdgcn_sched_barrier(0)
    Unit cur, nxt; int ui = 0;
    if (!S.next(0, cur)) return;
    f32x4 acc[2][2][4][2];
#pragma unroll
    for (int a = 0; a < 2; ++a)
#pragma unroll
        for (int b = 0; b < 2; ++b)
#pragma unroll
            for (int m = 0; m < 4; ++m)
#pragma unroll
                for (int n = 0; n < 2; ++n) acc[a][b][m][n] = (f32x4){0.f, 0.f, 0.f, 0.f};
    bf16x8 At[4][2], B0[2][2], B1[2][2];
    const char* cA = (const char*)(g.A + (size_t)cur.z * g.Az) + (size_t)cur.pm * tstepA; const char* cB = (const char*)(g.Bt + (size_t)cur.z * g.Bz) + (size_t)cur.pn * tstepB;
    S.a_ready(cur);
    if constexpr (SP2) {
        PG8_STAGE(PG8_SB(0, 0), cB, voffB); PG8_STAGE(PG8_SB(0, 1), cB + hstepB, voffB); PG8_STAGE(PG8_SA(0, 0), cA, voffA); PG8_STAGE(PG8_SA(0, 1), cA + hstepA, voffA);
        if (wr == 1) PG8_BAR;
        PG8_WAIT_V(2); PG8_BAR;
        PG8_STAGE(PG8_SB(1, 0), cB + kstep, voffB); PG8_STAGE(PG8_SA(1, 0), cA + kstep, voffA); PG8_STAGE(PG8_SB(1, 1), cB + hstepB + kstep, voffB);
        PG8_WAIT_V(6); PG8_BAR;
    } else {
        PG8_STAGE(PG8_SB(0, 0), cB, voffB); PG8_STAGE(PG8_SA(0, 0), cA, voffA); PG8_STAGE(PG8_SB(0, 1), cB + hstepB, voffB); PG8_STAGE(PG8_SA(0, 1), cA + hstepA, voffA);
        if (wr == 1) PG8_BAR;
        PG8_WAIT_V(4); PG8_BAR;
        PG8_STAGE(PG8_SB(1, 0), cB + kstep, voffB); PG8_STAGE(PG8_SA(1, 0), cA + kstep, voffA); PG8_STAGE(PG8_SB(1, 1), cB + hstepB + kstep, voffB);
        PG8_WAIT_V(6); PG8_BAR;
    }
    for (;;) {
        const bool has_next = S.next(ui + 1, nxt);
        const char* nA = has_next ? (const char*)(g.A + (size_t)nxt.z * g.Az) + (size_t)nxt.pm * tstepA : cA; const char* nB = has_next ? (const char*)(g.Bt + (size_t)nxt.z * g.Bz) + (size_t)nxt.pn * tstepB : cB;
        for (int t = 0; t < nt; t += 2) {
            const bool last = (t == nt - 2);
            const char* a1 = cA + (size_t)(t + 1) * kstep;
            const char* a2 = last ? nA : cA + (size_t)(t + 2) * kstep; const char* b2 = last ? nB : cB + (size_t)(t + 2) * kstep;
            const char* a3 = a2 + kstep; const char* b3 = b2 + kstep;
            if (last && has_next) S.a_ready(nxt);
            if constexpr (SP2) {
            PG8_LDB(B0, 0, 0); PG8_LDB(B1, 0, 1); PG8_SCHED; PG8_LDA(At, 0, 0); PG8_STAGE(PG8_SA(1, 1), a1 + hstepA, voffA);
            PG8_WAIT_V(8); PG8_WAIT_L(0); PG8_BAR; PG8_MMA(0, 0, At, B0); PG8_MMA(0, 1, At, B1); PG8_BAR; PG8_SCHED;
            PG8_LDA(At, 0, 1); PG8_STAGE(PG8_SB(0, 0), b2, voffB); PG8_STAGE(PG8_SB(0, 1), b2 + hstepB, voffB); PG8_STAGE(PG8_SA(0, 0), a2, voffA);
            PG8_WAIT_V(8); PG8_WAIT_L(0); PG8_BAR; PG8_MMA(1, 0, At, B0); PG8_MMA(1, 1, At, B1); PG8_BAR; PG8_SCHED;
            PG8_LDB(B0, 1, 0); PG8_LDB(B1, 1, 1); PG8_SCHED; PG8_LDA(At, 1, 0); PG8_STAGE(PG8_SA(0, 1), a2 + hstepA, voffA);
            PG8_WAIT_V(8); PG8_WAIT_L(0); PG8_BAR; PG8_MMA(0, 0, At, B0); PG8_MMA(0, 1, At, B1); PG8_BAR; PG8_SCHED;
            PG8_LDA(At, 1, 1); PG8_STAGE(PG8_SB(1, 0), b3, voffB); PG8_STAGE(PG8_SB(1, 1), b3 + hstepB, voffB); PG8_STAGE(PG8_SA(1, 0), a3, voffA);
            PG8_WAIT_V(8); PG8_WAIT_L(0); PG8_BAR; PG8_MMA(1, 0, At, B0); PG8_MMA(1, 1, At, B1); PG8_BAR; PG8_SCHED;
            } else {
            PG8_LDB(B0, 0, 0); PG8_SCHED; PG8_LDA(At, 0, 0); PG8_STAGE(PG8_SA(1, 1), a1 + hstepA, voffA);
            PG8_WAIT_L(8); PG8_BAR; PG8_WAIT_L(0); PG8_MMA(0, 0, At, B0); PG8_BAR; PG8_SCHED;
            PG8_LDB(B1, 0, 1); PG8_STAGE(PG8_SB(0, 0), b2, voffB);
            PG8_BAR; PG8_WAIT_L(0); PG8_MMA(0, 1, At, B1); PG8_BAR;
            PG8_LDA(At, 0, 1); PG8_STAGE(PG8_SA(0, 0), a2, voffA);
            PG8_BAR; PG8_WAIT_L(0); PG8_MMA(1, 0, At, B0); PG8_BAR; PG8_SCHED;
            PG8_STAGE(PG8_SB(0, 1), b2 + hstepB, voffB);
            PG8_WAIT_V(6); PG8_BAR; PG8_MMA(1, 1, At, B1); PG8_BAR;
            PG8_LDB(B0, 1, 0); PG8_SCHED; PG8_LDA(At, 1, 0); PG8_STAGE(PG8_SA(0, 1), a2 + hstepA, voffA);
            PG8_WAIT_L(8); PG8_BAR; PG8_WAIT_L(0); PG8_MMA(0, 0, At, B0); PG8_BAR; PG8_SCHED;
            PG8_LDB(B1, 1, 1); PG8_STAGE(PG8_SB(1, 0), b3, voffB);
            PG8_BAR; PG8_WAIT_L(0); PG8_MMA(0, 1, At, B1); PG8_BAR;
            PG8_LDA(At, 1, 1); PG8_STAGE(PG8_SA(1, 0), a3, voffA);
            PG8_BAR; PG8_WAIT_L(0); PG8_MMA(1, 0, At, B0); PG8_BAR; PG8_SCHED;
            PG8_STAGE(PG8_SB(1, 1), b3 + hstepB, voffB);
            PG8_WAIT_V(6); PG8_BAR; PG8_MMA(1, 1, At, B1); PG8_BAR;
            }
        }
        if constexpr (ALIGN_EPI) { if (wr == 0) PG8_BAR; }
        bool keep = false; if constexpr (!Epi::AFTER_DRAIN) { keep = E(acc, cur, wr, wc, fr, fq); S.done(cur); }
        if (!has_next) break;
        if (!keep)
#pragma unroll
        for (int a = 0; a < 2; ++a)
#pragma unroll
            for (int b = 0; b < 2; ++b)
#pragma unroll
                for (int m = 0; m < 4; ++m)
#pragma unroll
                    for (int n = 0; n < 2; ++n) acc[a][b][m][n] = (f32x4){0.f, 0.f, 0.f, 0.f};
        cur = nxt; cA = nA; cB = nB; ++ui;
        if constexpr (ALIGN_EPI) { if (wr == 1) PG8_BAR; }
    }
    PG8_WAIT_V(0);
    if constexpr (!ALIGN_EPI) { if (wr == 0) PG8_BAR; }
    PG8_BAR;
    if constexpr (Epi::AFTER_DRAIN) { E.fused(acc, cur, wr, wc, fr, fq, lds, wid, lane); S.done(cur); }
#undef PG8_SA
#undef PG8_SB
#undef PG8_STAGE
#undef PG8_LDA
#undef PG8_LDB
#undef PG8_MMA
#undef PG8_WAIT_V
#undef PG8_WAIT_L
#undef PG8_BAR
#undef PG8_SCHED
}
}

#ifndef PG8_SP2
#define PG8_SP2 true
#endif
#ifndef PG8_ALIGN
#define PG8_ALIGN true
#endif

#include <hip/hip_bf16.h>
#include <cmath>
namespace attn_body {
using bf16=__hip_bfloat16;
using bf16x8=__attribute__((ext_vector_type(8)))short;
using s16x4=__attribute__((ext_vector_type(4)))short;
using f32x16=__attribute__((ext_vector_type(16)))float;
using u32x4=__attribute__((ext_vector_type(4)))unsigned;
using f32x4v=__attribute__((ext_vector_type(4)))float;
constexpr int SEQ=4096,D=64;
constexpr int NW=8,QBLK=32,QB=QBLK*NW,KVBLK=64,NQB=SEQ/QB;
constexpr int ATTN_UNIT_ROWS=QB;
__device__ __forceinline__ int crow(int r,int hi){return (r&3)+8*(r>>2)+4*hi;}
#define SBAR() __builtin_amdgcn_sched_barrier(0)
__device__ __forceinline__ void cmask(f32x16&p0,f32x16&p1,int jb,int qrel,int hi){
  const float NEG=-INFINITY; int kb=64*jb+4*hi;
  #pragma unroll
  for(int r=0;r<16;++r){int kv=kb+(r&3)+8*(r>>2); if(kv>qrel)p0[r]=NEG; if(kv+32>qrel)p1[r]=NEG;}
}

constexpr int NSLOT=3, SLOTB=8192;
constexpr int LDS_K=0, LDS_V=NSLOT*SLOTB, LDS_WS=2*NSLOT*SLOTB, LDS_OST=LDS_WS+NW*64*4, LDS_BIAS=LDS_OST+NW*4096, LDS_BYTES=LDS_BIAS+SEQ*4;
constexpr float C2=0.125f*1.4426950408889634f;
__device__ __forceinline__ void glds16(const void*gsrc,unsigned lds_dst){unsigned keep;
  asm volatile("s_mov_b32 %0, m0\n\ts_mov_b32 m0, %2\n\ts_nop 0\n\tglobal_load_lds_dwordx4 %1, off\n\ts_mov_b32 m0, %0":"=&s"(keep):"v"(gsrc),"s"(lds_dst):"memory");}
__device__ __forceinline__ float max3f(float a,float b,float c){float r;asm("v_max3_f32 %0, %1, %2, %3":"=v"(r):"v"(a),"v"(b),"v"(c));return r;}
__device__ __forceinline__ float max2f(float a,float b){float r;asm("v_max_f32_e32 %0, %1, %2":"=v"(r):"v"(a),"v"(b));return r;}
__device__ __forceinline__ float fadd_s(float a,float b){float r;asm("v_add_f32_e32 %0, %1, %2":"=v"(r):"v"(a),"v"(b));return r;}
__device__ __forceinline__ float fsub_s(float a,float b){float r;asm("v_sub_f32_e32 %0, %1, %2":"=v"(r):"v"(a),"v"(b));return r;}
typedef float f32x2_t __attribute__((ext_vector_type(2))); typedef __bf16 bf16x2_t __attribute__((ext_vector_type(2)));
__device__ __forceinline__ unsigned cvtpk_s(float lo,float hi){f32x2_t v={lo,hi};bf16x2_t b=__builtin_convertvector(v,bf16x2_t);return __builtin_bit_cast(unsigned,b);}
#define WAIT_BAR(N) asm volatile("s_waitcnt vmcnt(" #N ") lgkmcnt(0)\n\ts_barrier":::"memory")

__device__ __forceinline__ void qkt(f32x16&p0,f32x16&p1,const char*Kslot,const bf16x8*qr,int r32,int hi){
  const char*kb=Kslot+hi*1024+r32*16;
  #pragma unroll
  for(int d0=0;d0<4;++d0){
    const bf16x8 b0=*reinterpret_cast<const bf16x8*>(kb+d0*2048);
    const bf16x8 b1=*reinterpret_cast<const bf16x8*>(kb+d0*2048+512);
    {p0=__builtin_amdgcn_mfma_f32_32x32x16_bf16(b0,qr[d0],p0,0,0,0);p1=__builtin_amdgcn_mfma_f32_32x32x16_bf16(b1,qr[d0],p1,0,0,0);}}
}
typedef __attribute__((address_space(3))) const char* lds_cptr;
typedef short v4i16_t __attribute__((ext_vector_type(4)));
__device__ __forceinline__ void kload8(bf16x8*kf,lds_cptr kp){
  kf[0]=*(const __attribute__((address_space(3))) bf16x8*)(kp);      kf[1]=*(const __attribute__((address_space(3))) bf16x8*)(kp+512);
  kf[2]=*(const __attribute__((address_space(3))) bf16x8*)(kp+2048); kf[3]=*(const __attribute__((address_space(3))) bf16x8*)(kp+2560);
  kf[4]=*(const __attribute__((address_space(3))) bf16x8*)(kp+4096); kf[5]=*(const __attribute__((address_space(3))) bf16x8*)(kp+4608);
  kf[6]=*(const __attribute__((address_space(3))) bf16x8*)(kp+6144); kf[7]=*(const __attribute__((address_space(3))) bf16x8*)(kp+6656);
}
__device__ __forceinline__ void kload2(bf16x8*kf,lds_cptr kp,int j){ kf[2*j]=*(const __attribute__((address_space(3))) bf16x8*)(kp+j*2048); kf[2*j+1]=*(const __attribute__((address_space(3))) bf16x8*)(kp+j*2048+512); }
__device__ __forceinline__ s16x4 vtr(lds_cptr p){ return __builtin_bit_cast(s16x4,__builtin_amdgcn_ds_read_tr16_b64_v4i16((__attribute__((address_space(3))) v4i16_t*)p)); }
__device__ __forceinline__ float rowmax(const f32x16&p0,const f32x16&p1){
  float a=max3f(p0[0],p0[1],p1[0]),b=max3f(p0[2],p0[3],p1[1]);a=max3f(a,p1[2],p1[3]);
  #pragma unroll
  for(int r=4;r<16;r+=4){a=max3f(a,p0[r],p0[r+1]);b=max3f(b,p0[r+2],p0[r+3]);a=max3f(a,p1[r],p1[r+1]);b=max3f(b,p1[r+2],p1[r+3]);}
  const float m=max2f(a,b);
  auto rr=__builtin_amdgcn_permlane32_swap(__float_as_uint(m),__float_as_uint(m),false,false);
  return max2f(__uint_as_float(rr[0]),__uint_as_float(rr[1]));
}
__device__ __forceinline__ void pv(f32x16*o,int vb,bf16x8 pa0,bf16x8 pa1,bf16x8 pa2,bf16x8 pa3){
  #pragma unroll
  for(int d0=0;d0<2;++d0){s16x4 lo[4],hi[4];
    #pragma unroll
    for(int ks=0;ks<4;++ks){
      asm volatile("ds_read_b64_tr_b16 %0,%1 offset:%c2":"=&v"(lo[ks]):"v"(vb),"i"(d0*4096+ks*1024):"memory");
      asm volatile("ds_read_b64_tr_b16 %0,%1 offset:%c2":"=&v"(hi[ks]):"v"(vb),"i"(d0*4096+ks*1024+512):"memory");}
    asm volatile("s_waitcnt lgkmcnt(0)":::"memory");SBAR();
    #define PK(k) (bf16x8){lo[k][0],lo[k][1],lo[k][2],lo[k][3],hi[k][0],hi[k][1],hi[k][2],hi[k][3]}
    o[d0]=__builtin_amdgcn_mfma_f32_32x32x16_bf16(pa0,PK(0),o[d0],0,0,0);
    o[d0]=__builtin_amdgcn_mfma_f32_32x32x16_bf16(pa1,PK(1),o[d0],0,0,0);
    o[d0]=__builtin_amdgcn_mfma_f32_32x32x16_bf16(pa2,PK(2),o[d0],0,0,0);
    o[d0]=__builtin_amdgcn_mfma_f32_32x32x16_bf16(pa3,PK(3),o[d0],0,0,0);
    #undef PK
  }
}

#ifndef ATTN_STORE16
#define ATTN_STORE16(p,v) (*(u32x4*)(p)=(v))
#endif
template<int THRL,bool HB,bool VW2> __device__ __forceinline__ void attn_unit(int qb,const bf16*Qp,const bf16*Kh,const bf16*Vh,bf16*Op,int ldq,int ldo,const float*biasg,const bf16*Gp,char*shm){
  int tid_=threadIdx.x; asm volatile("":"+v"(tid_)); const int tid=tid_,lane=tid&63,r32=lane&31,hi=lane>>5; const int wid=__builtin_amdgcn_readfirstlane(tid>>6);
  const int q0=qb*QB;
  constexpr int VS=VW2?2:1, L_WS=LDS_V+NSLOT*SLOTB*VS, L_OST=L_WS+NW*64*4, L_BIAS=L_OST+NW*4096;
  static_assert(!(HB&&VW2)&&L_BIAS+(HB?SEQ*4:0)<=131072,"attention LDS map");
  const bf16*Qw=Qp+(long)(q0+wid*QBLK)*ldq;
  const unsigned lds0=(unsigned)(uintptr_t)shm;
  float*wsf=(float*)(shm+L_WS)+wid*64;
  const bf16*ksrc=Kh+(long)lane*ldq+wid*8;
  const bf16*vsrc=Vh+(long)(16*(wid&3)+(lane>>2))*ldq+(wid>>2)*32+(lane&3)*8;
  const unsigned kdst=lds0+LDS_K+wid*1024, vdst=lds0+LDS_V+wid*1024;
  #define DMA_K(t,slot) glds16(ksrc+(long)(NT-1-(t))*KVBLK*ldq,(unsigned)__builtin_amdgcn_readfirstlane(kdst+(slot)))
  #define DMA_V(t,slot) do{ glds16(vsrc+(long)(NT-1-(t))*KVBLK*ldq,(unsigned)__builtin_amdgcn_readfirstlane(vdst+(slot)*VS)); \
    if(VW2) glds16(vsrc+(long)(NT-1-(t))*KVBLK*ldq+64,(unsigned)__builtin_amdgcn_readfirstlane(vdst+(slot)*VS+8192)); }while(0)
  const int vb0=(int)(lds0+LDS_V)+((lane>>4)&1)*32+(lane&3)*8+(4*hi+((lane&15)>>2))*64;
  const char*Kbase=shm+LDS_K; bf16x8 kf[8];
  const lds_cptr shm3=(lds_cptr)shm; const lds_cptr kp0=shm3+LDS_K+hi*1024+r32*16; const lds_cptr vp0=shm3+LDS_V+((lane>>4)&1)*32+(lane&3)*8+(4*hi+((lane&15)>>2))*64;
  const int NT=(q0+QB)/KVBLK;
  if(HB){ float*bl=(float*)(shm+L_BIAS); for(int i=tid;i<q0+QB;i+=NW*64) bl[i]=biasg[i]; }
  DMA_K(0,0);DMA_V(0,0);DMA_K(1,SLOTB);
  bf16x8 qr[4];
  #pragma unroll
  for(int d0=0;d0<4;++d0)qr[d0]=*reinterpret_cast<const bf16x8*>(&Qw[(long)r32*ldq+d0*16+hi*8]);
  float mhat=0.f,l_reg=0.f;f32x16 o[4];o[0]=f32x16{};o[1]=f32x16{};o[2]=f32x16{};o[3]=f32x16{};f32x16 negm=f32x16{};if(!HB&&!VW2)asm volatile("":"+v"(negm));
  const int qrel=wid*QBLK+r32;
  const lds_cptr bias3=shm3+L_BIAS+hi*16;
  #define BLD(P0,P1,tt) do{ const lds_cptr bp_=bias3+(NT-1-(tt))*256; \
    _Pragma("unroll") for(int g_=0;g_<4;++g_){ const f32x4v x_=*(const __attribute__((address_space(3))) f32x4v*)(bp_+32*g_); const f32x4v y_=*(const __attribute__((address_space(3))) f32x4v*)(bp_+128+32*g_); \
      P0[4*g_]=x_[0];P0[4*g_+1]=x_[1];P0[4*g_+2]=x_[2];P0[4*g_+3]=x_[3]; P1[4*g_]=y_[0];P1[4*g_+1]=y_[1];P1[4*g_+2]=y_[2];P1[4*g_+3]=y_[3]; } }while(0)
  #define BSUB(P0,P1) do{ _Pragma("unroll") for(int r=0;r<16;++r){P0[r]-=mhat;P1[r]-=mhat;} }while(0)
  #define CMASK(P0,P1,t) do{int jb_=3-(t); if(jb_>=0)cmask(P0,P1,jb_,qrel,hi);}while(0)
  bool resc=false;
  #define START(P0,P1) do{ const float rm=rowmax(P0,P1); resc=false; \
    if(__any(rm>(float)THRL)){ const float dl=__builtin_fmaxf(rm,0.f); mhat=fadd_s(mhat,dl); \
      _Pragma("unroll") for(int r=0;r<16;++r){P0[r]=fsub_s(P0[r],dl);P1[r]=fsub_s(P1[r],dl);} \
      if(!HB&&!VW2){ _Pragma("unroll") for(int r=0;r<16;++r)negm[r]=-mhat; asm volatile("":"+v"(negm)); } } \
    _Pragma("unroll") for(int r=0;r<16;++r)P0[r]=__builtin_amdgcn_exp2f(P0[r]); }while(0)
  #define RESC() do{ if(resc){ asm volatile("s_waitcnt lgkmcnt(0)":::"memory"); \
      _Pragma("unroll") for(int d_=0;d_<2*VS;++d_) _Pragma("unroll") for(int r=0;r<16;++r)o[d_][r]*=wsf[crow(r,hi)]; } }while(0)
  f32x16 pA0,pA1,pB0,pB1;
  int sl_prev=0,sl_cur=0,sl_next=SLOTB;
  #define ROT() do{sl_prev=sl_cur;sl_cur=sl_next;sl_next=(sl_next==(NSLOT-1)*SLOTB)?0:sl_next+SLOTB;}while(0)
  DMA_K(2,2*SLOTB);
  #define WB3() do{ if(VW2){WAIT_BAR(4);}else{WAIT_BAR(3);} }while(0)
  #define WB2() do{ if(VW2){WAIT_BAR(3);}else{WAIT_BAR(2);} }while(0)
  #define WB1() do{ if(VW2){WAIT_BAR(2);}else{WAIT_BAR(1);} }while(0)
  WB3();
  if(HB){BLD(pA0,pA1,0);}else if(VW2){pA0=f32x16{};pA1=f32x16{};}else{pA0=negm;pA1=negm;}
  qkt(pA0,pA1,Kbase,qr,r32,hi);asm volatile("s_nop 15\n\ts_nop 7":"+v"(pA0),"+v"(pA1));CMASK(pA0,pA1,0);
  START(pA0,pA1);
  if(HB){BLD(pB0,pB1,1); BSUB(pB0,pB1);}
  _Pragma("unroll") for(int r=0;r<16;++r)pA1[r]=__builtin_amdgcn_exp2f(pA1[r]);
  WAIT_BAR(0);
  DMA_K(3,0);DMA_V(1,SLOTB);
  ROT();
  kload8(kf,kp0+sl_cur);
  WB2();
  s16x4 vlo[8],vhi[8]; u32x4 pw0,pw1,pw2,pw3;
  #define PKW(P,B) cvtpk_s(P[B],P[B+1])
  #define PAF(k) __builtin_bit_cast(bf16x8,pw##k)
  #define VFR(i) (bf16x8){vlo[i][0],vlo[i][1],vlo[i][2],vlo[i][3],vhi[i][0],vhi[i][1],vhi[i][2],vhi[i][3]}
  #define PIN(x) asm volatile("":"+v"(x))
  #define MX3(a,b,c) __builtin_fmaxf(__builtin_fmaxf((a),(b)),(c))
  #define GAPA(MF,A0,A1,A2,A3,W0,W1,PW) do{ MF; sacc+=A0; sacc+=A1; sacc+=A2; sacc+=A3; PIN(sacc); W0; W1; PIN(PW); SBAR(); }while(0)
  #define EX(v) __builtin_amdgcn_exp2f(v)
  #define GAPB(MF,X,B) do{ MF; X[B]=EX(X[B]); X[B+1]=EX(X[B+1]); X[B+2]=EX(X[B+2]); X[B+3]=EX(X[B+3]); PIN(X); SBAR(); }while(0)
  #define GAPB2(MF,X,B) do{ MF; X[B]=EX(X[B]); X[B+1]=EX(X[B+1]); PIN(X); SBAR(); }while(0)
  #define VRD(i) do{ vlo[i]=vtr(vp_+(((i)>>2)*4096+((i)&3)*1024)); vhi[i]=vtr(vp_+(((i)>>2)*4096+((i)&3)*1024+512)); }while(0)
  #define VRDH(i) do{ vlo[i]=vtr(vp_+8192+(((i)>>2)*4096+((i)&3)*1024)); vhi[i]=vtr(vp_+8192+(((i)>>2)*4096+((i)&3)*1024+512)); }while(0)
  #define KRD(G,j) do{ if(G){ kload2(kf,kp0+sl_next,j); SBAR(); } }while(0)
  #define STEP(C0,C1,P0,P1,t,GK,GV,GL) do{ SBAR(); \
    const lds_cptr vp_=vp0+sl_prev*VS; \
    if(VW2){ const float nm_=-mhat; _Pragma("unroll") for(int r=0;r<16;++r){C0[r]=nm_;C1[r]=nm_;} } \
    VRD(0); SBAR(); float sacc=(P0[0]+P0[1]); \
    GAPA(C0=__builtin_amdgcn_mfma_f32_32x32x16_bf16(kf[0],qr[0],(HB||VW2)?C0:negm,0,0,0), P0[2],P0[3],P0[4],P0[5],     pw0[0]=PKW(P0,0), pw0[1]=PKW(P0,2), pw0); \
    VRD(4); SBAR(); GAPA(C1=__builtin_amdgcn_mfma_f32_32x32x16_bf16(kf[1],qr[0],(HB||VW2)?C1:negm,0,0,0), P0[6],P0[7],P0[8],P0[9],     pw0[2]=PKW(P0,4), pw0[3]=PKW(P0,6), pw0); \
    VRD(1); SBAR(); GAPA(C0=__builtin_amdgcn_mfma_f32_32x32x16_bf16(kf[2],qr[1],C0,0,0,0),   P0[10],P0[11],P0[12],P0[13], pw1[0]=PKW(P0,8), pw1[1]=PKW(P0,10), pw1); \
    VRD(5); SBAR(); GAPA(C1=__builtin_amdgcn_mfma_f32_32x32x16_bf16(kf[3],qr[1],C1,0,0,0),   P0[14],P0[15],P1[0],P1[1],   pw1[2]=PKW(P0,12),pw1[3]=PKW(P0,14), pw1); \
    VRD(2); SBAR(); GAPA(C0=__builtin_amdgcn_mfma_f32_32x32x16_bf16(kf[4],qr[2],C0,0,0,0),   P1[2],P1[3],P1[4],P1[5],     pw2[0]=PKW(P1,0), pw2[1]=PKW(P1,2), pw2); \
    VRD(6); SBAR(); GAPA(C1=__builtin_amdgcn_mfma_f32_32x32x16_bf16(kf[5],qr[2],C1,0,0,0),   P1[6],P1[7],P1[8],P1[9],     pw2[2]=PKW(P1,4), pw2[3]=PKW(P1,6), pw2); \
    VRD(3); SBAR(); GAPA(C0=__builtin_amdgcn_mfma_f32_32x32x16_bf16(kf[6],qr[3],C0,0,0,0),   P1[10],P1[11],P1[12],P1[13], pw3[0]=PKW(P1,8), pw3[1]=PKW(P1,10), pw3); \
    VRD(7); SBAR(); GAPA(C1=__builtin_amdgcn_mfma_f32_32x32x16_bf16(kf[7],qr[3],C1,0,0,0),   P1[14],P1[15],0.f,0.f,       pw3[2]=PKW(P1,12),pw3[3]=PKW(P1,14), pw3); \
    l_reg+=sacc; \
    if(GK){DMA_K((t)+3,sl_cur);} if(GV){DMA_V((t)+1,sl_next);} \
    CMASK(C0,C1,t); \
    { float a=MX3(C0[0],C0[1],C1[0]),b=MX3(C0[2],C0[3],C1[1]); a=MX3(a,C1[2],C1[3]); \
      _Pragma("unroll") for(int r=4;r<16;r+=4){a=MX3(a,C0[r],C0[r+1]);b=MX3(b,C0[r+2],C0[r+3]);a=MX3(a,C1[r],C1[r+1]);b=MX3(b,C1[r+2],C1[r+3]);} \
      float rm=__builtin_fmaxf(a,b); { auto rr=__builtin_amdgcn_permlane32_swap(__float_as_uint(rm),__float_as_uint(rm),false,false); rm=__builtin_fmaxf(__uint_as_float(rr[0]),__uint_as_float(rr[1])); } \
      resc=false; \
      if(__builtin_expect(__any(rm>(float)THRL),0)){ const float dl=__builtin_fmaxf(rm,0.f); mhat+=dl; \
        _Pragma("unroll") for(int r=0;r<16;++r){C0[r]-=dl;C1[r]-=dl;} \
        if(!HB&&!VW2){ _Pragma("unroll") for(int r=0;r<16;++r)negm[r]=-mhat; asm volatile("":"+v"(negm)); } \
        const float f=__builtin_amdgcn_exp2f(-dl); l_reg*=f; if(hi==0)wsf[r32]=f; resc=true; } } \
    SBAR(); \
    if(HB&&(GL)){ BLD(P0,P1,(t)+1); SBAR(); } \
    if(!VW2){ \
    GAPB(o[0]=__builtin_amdgcn_mfma_f32_32x32x16_bf16(PAF(0),VFR(0),o[0],0,0,0), C0,0); \
    GAPB(o[1]=__builtin_amdgcn_mfma_f32_32x32x16_bf16(PAF(0),VFR(4),o[1],0,0,0), C0,4); \
    KRD(GL,0); GAPB(o[0]=__builtin_amdgcn_mfma_f32_32x32x16_bf16(PAF(1),VFR(1),o[0],0,0,0), C0,8); \
    KRD(GL,1); GAPB(o[1]=__builtin_amdgcn_mfma_f32_32x32x16_bf16(PAF(1),VFR(5),o[1],0,0,0), C0,12); \
    KRD(GL,2); GAPB(o[0]=__builtin_amdgcn_mfma_f32_32x32x16_bf16(PAF(2),VFR(2),o[0],0,0,0), C1,0); \
    KRD(GL,3); GAPB(o[1]=__builtin_amdgcn_mfma_f32_32x32x16_bf16(PAF(2),VFR(6),o[1],0,0,0), C1,4); \
    GAPB(o[0]=__builtin_amdgcn_mfma_f32_32x32x16_bf16(PAF(3),VFR(3),o[0],0,0,0), C1,8); \
    GAPB(o[1]=__builtin_amdgcn_mfma_f32_32x32x16_bf16(PAF(3),VFR(7),o[1],0,0,0), C1,12); \
    } else {   \
    GAPB2(o[0]=__builtin_amdgcn_mfma_f32_32x32x16_bf16(PAF(0),VFR(0),o[0],0,0,0), C0,0); VRDH(0); SBAR(); \
    GAPB2(o[1]=__builtin_amdgcn_mfma_f32_32x32x16_bf16(PAF(0),VFR(4),o[1],0,0,0), C0,2); VRDH(4); SBAR(); \
    KRD(GL,0); GAPB2(o[0]=__builtin_amdgcn_mfma_f32_32x32x16_bf16(PAF(1),VFR(1),o[0],0,0,0), C0,4); VRDH(1); SBAR(); \
    KRD(GL,1); GAPB2(o[1]=__builtin_amdgcn_mfma_f32_32x32x16_bf16(PAF(1),VFR(5),o[1],0,0,0), C0,6); VRDH(5); SBAR(); \
    KRD(GL,2); GAPB2(o[0]=__builtin_amdgcn_mfma_f32_32x32x16_bf16(PAF(2),VFR(2),o[0],0,0,0), C0,8); VRDH(2); SBAR(); \
    KRD(GL,3); GAPB2(o[1]=__builtin_amdgcn_mfma_f32_32x32x16_bf16(PAF(2),VFR(6),o[1],0,0,0), C0,10); VRDH(6); SBAR(); \
    GAPB2(o[0]=__builtin_amdgcn_mfma_f32_32x32x16_bf16(PAF(3),VFR(3),o[0],0,0,0), C0,12); VRDH(3); SBAR(); \
    GAPB2(o[1]=__builtin_amdgcn_mfma_f32_32x32x16_bf16(PAF(3),VFR(7),o[1],0,0,0), C0,14); VRDH(7); SBAR(); \
    GAPB2(o[2]=__builtin_amdgcn_mfma_f32_32x32x16_bf16(PAF(0),VFR(0),o[2],0,0,0), C1,0); \
    GAPB2(o[3]=__builtin_amdgcn_mfma_f32_32x32x16_bf16(PAF(0),VFR(4),o[3],0,0,0), C1,2); \
    GAPB2(o[2]=__builtin_amdgcn_mfma_f32_32x32x16_bf16(PAF(1),VFR(1),o[2],0,0,0), C1,4); \
    GAPB2(o[3]=__builtin_amdgcn_mfma_f32_32x32x16_bf16(PAF(1),VFR(5),o[3],0,0,0), C1,6); \
    GAPB2(o[2]=__builtin_amdgcn_mfma_f32_32x32x16_bf16(PAF(2),VFR(2),o[2],0,0,0), C1,8); \
    GAPB2(o[3]=__builtin_amdgcn_mfma_f32_32x32x16_bf16(PAF(2),VFR(6),o[3],0,0,0), C1,10); \
    GAPB2(o[2]=__builtin_amdgcn_mfma_f32_32x32x16_bf16(PAF(3),VFR(3),o[2],0,0,0), C1,12); \
    GAPB2(o[3]=__builtin_amdgcn_mfma_f32_32x32x16_bf16(PAF(3),VFR(7),o[3],0,0,0), C1,14); \
    } \
    if(HB&&(GL)){ BSUB(P0,P1); } \
    }while(0)
  int t=1;
  #undef CMASK
  #define CMASK(P0,P1,t) do{int jb_=3-(t); if(jb_>=0)cmask(P0,P1,jb_,qrel,hi);}while(0)
  for(;t+5<NT;t+=2){
    STEP(pB0,pB1,pA0,pA1,t,true,true,true);     WB2(); RESC(); ROT();
    STEP(pA0,pA1,pB0,pB1,t+1,true,true,true);   WB2(); RESC(); ROT();
  }
  #undef CMASK
  #define CMASK(P0,P1,t) do{int jb_=3-(t); if(jb_>=0)cmask(P0,P1,jb_,qrel,hi);}while(0)
  #define ENDW(tt) do{ if((tt)+3<NT){WB2();} else if((tt)+2<NT){WB1();} else {WAIT_BAR(0);} }while(0)
  for(;t+1<NT;t+=2){
    STEP(pB0,pB1,pA0,pA1,t,(t+3<NT),(t+1<NT),(t+1<NT));       ENDW(t);   RESC(); ROT();
    STEP(pA0,pA1,pB0,pB1,t+1,(t+4<NT),(t+2<NT),(t+2<NT));     ENDW(t+1); RESC(); ROT();
  }
  STEP(pB0,pB1,pA0,pA1,NT-1,false,false,false); RESC();
  { float sacc=pB0[0]+pB0[1]; _Pragma("unroll") for(int r=2;r<16;++r)sacc+=pB0[r]; _Pragma("unroll") for(int r=0;r<16;++r)sacc+=pB1[r]; l_reg+=sacc;
    pw0=(u32x4){PKW(pB0,0),PKW(pB0,2),PKW(pB0,4),PKW(pB0,6)};pw1=(u32x4){PKW(pB0,8),PKW(pB0,10),PKW(pB0,12),PKW(pB0,14)};pw2=(u32x4){PKW(pB1,0),PKW(pB1,2),PKW(pB1,4),PKW(pB1,6)};pw3=(u32x4){PKW(pB1,8),PKW(pB1,10),PKW(pB1,12),PKW(pB1,14)};
    SBAR(); pv(o,vb0+sl_cur*VS,PAF(0),PAF(1),PAF(2),PAF(3)); if(VW2){ SBAR(); pv(o+2,vb0+sl_cur*VS+8192,PAF(0),PAF(1),PAF(2),PAF(3)); } }
  #undef PKW
  #undef PAF
  #undef VFR
  #undef PIN
  #undef MX3
  #undef GAPA
  #undef GAPB
  #undef GAPB2
  #undef EX
  #undef VRD
  #undef VRDH
  #undef KRD
  #undef STEP
  #undef ENDW
  {auto rr=__builtin_amdgcn_permlane32_swap(__float_as_uint(l_reg),__float_as_uint(l_reg),false,false);l_reg=__uint_as_float(rr[0])+__uint_as_float(rr[1]);}
  if(hi==0)wsf[32+r32]=l_reg;asm volatile("s_waitcnt lgkmcnt(0)":::"memory");
  u32x4 gt[4];
  if(HB){ const bf16*Gw=Gp+(long)(q0+wid*QBLK)*ldq;
    #pragma unroll
    for(int i=0;i<4;++i)gt[i]=*(const u32x4*)(Gw+(long)(i*8+(lane>>3))*ldq+(lane&7)*8); }
  float rli[16];
  #pragma unroll
  for(int r=0;r<16;++r)rli[r]=__builtin_amdgcn_rcpf(wsf[32+crow(r,hi)]);
  bf16*Ow=Op+(long)(q0+wid*QBLK)*ldo;
  { bf16*stg=(bf16*)(shm+L_OST)+wid*2048;
    #pragma unroll
    for(int hv=0;hv<VS;++hv){
    #pragma unroll
    for(int r=0;r<16;++r){const int orow=crow(r,hi);
      #pragma unroll
      for(int d0=0;d0<2;++d0)stg[orow*64+d0*32+r32]=__float2bfloat16(o[2*hv+d0][r]*rli[r]);}
    asm volatile("s_waitcnt lgkmcnt(0)":::"memory");
    #pragma unroll
    for(int i=0;i<4;++i){const int row=i*8+(lane>>3),ch=lane&7; u32x4 v=*(const u32x4*)(stg+row*64+ch*8);
      if(HB){ _Pragma("unroll") for(int e=0;e<4;++e){ const float ol=__uint_as_float(v[e]<<16),oh=__uint_as_float(v[e]&0xffff0000u),gl=__uint_as_float(gt[i][e]<<16),gh=__uint_as_float(gt[i][e]&0xffff0000u);
          const float sl=gl*__builtin_amdgcn_rcpf(1.f+__builtin_amdgcn_exp2f(fminf(-gl*1.4426950408889634f,100.f))),sh=gh*__builtin_amdgcn_rcpf(1.f+__builtin_amdgcn_exp2f(fminf(-gh*1.4426950408889634f,100.f)));
          v[e]=cvtpk_s(ol*sl,oh*sh); } }
      ATTN_STORE16(Ow+(long)row*ldo+hv*64+ch*8,v);}
    asm volatile("s_waitcnt lgkmcnt(0)":::"memory"); } }
  asm volatile("s_waitcnt lgkmcnt(0)\n\ts_barrier":::"memory");
  #undef BLD
  #undef BSUB
  #undef DMA_K
  #undef DMA_V
  #undef CMASK
  #undef START
  #undef RESC
  #undef ROT
  #undef WB3
  #undef WB2
  #undef WB1
}
constexpr int ATTN_LDS_BYTES=LDS_BYTES;
#undef SBAR
#undef WAIT_BAR
}


#include <hip/hip_cooperative_groups.h>
namespace cg = cooperative_groups;
#define LAS __attribute__((address_space(3)))
typedef unsigned short bf16r;
typedef unsigned v4u __attribute__((ext_vector_type(4)));
typedef float f32x4 __attribute__((ext_vector_type(4)));

constexpr int NWAVES = 8, NTHR = 512;
constexpr int NB = 4, SEQ = 4096, DM = 1024, T = NB * SEQ, DEPTH = 2, INW = 9224, PW = pg8::PW, NMG = 3072;
constexpr float RMS_EPS = 1e-6f;
constexpr size_t MiB = 1u << 20;
constexpr size_t WS_CTL = 0, CTL_BYTES = 65536;
constexpr size_t WS_LOGF = 2 * MiB;
constexpr size_t WS_CNEG = 2 * MiB + 512 * 1024;
constexpr size_t WS_CS = 3 * MiB;
constexpr size_t WS_W1 = 4 * MiB;
constexpr size_t WS_WMG = 16 * MiB;
constexpr size_t WS_WBR = 22 * MiB;
constexpr size_t WS_WO = 25 * MiB;
constexpr size_t WS_H = 28 * MiB;
constexpr size_t WS_OD = 60 * MiB;
constexpr size_t WS_P = 92 * MiB;
constexpr size_t WS_END = 284 * MiB;
constexpr int LDS_BYTES = 131072 + 256, LDS_MISC = 131072;
#ifndef PHM
#define PHM 127
#endif
#ifndef REP_A
#define REP_A 1
#endif
#ifndef REP_B
#define REP_B 1
#endif
#ifndef REP_W
#define REP_W 1
#endif
#ifndef REP_X
#define REP_X 1
#endif
#ifndef REP_Y
#define REP_Y 1
#endif
#ifndef REP_C
#define REP_C 1
#endif
#ifndef REP_G
#define REP_G 1
#endif
#ifndef REP_D
#define REP_D 1
#endif
#ifndef REP_E
#define REP_E 1
#endif
#ifndef REP_S
#define REP_S 0
#endif

__device__ __forceinline__ unsigned pk2(float lo, float hi) { return pg8::cvt_pk_bf16(lo, hi); }
__device__ __forceinline__ float wave_sum(float v) {
#pragma unroll
    for (int o = 1; o < 64; o <<= 1) v += __shfl_xor(v, o);
    return v;
}
__device__ __forceinline__ float silu_f(float v) { return v * __builtin_amdgcn_rcpf(1.f + __builtin_amdgcn_exp2f(fminf(-v * 1.4426950408889634f, 100.f))); }

template <int MODE> __device__ __forceinline__ int cmap(int n) {
    if (MODE == 1) {
        int o = n + (n >= 1536 ? 8 : 0);
        if (n >= 2048 && n < 3072) { const int w = n & 63; if (w < 16) o = (n & ~63) + 8 + ((w & 1) ? 8 + (w >> 1) : (w >> 1)); }
        return o;
    }
    if (MODE == 2) return 6152 + n;
    return n;
}
template <int MODE> __device__ __forceinline__ void transpose_item(const float* W, int ldw, int K, int N, bf16r* WT, LAS float* scr, int item, int lane) {
    const int nblk = N / 32, kb = item / nblk, nb = item % nblk, k0 = 64 * kb, n0 = 32 * nb;
    const int oc = cmap<MODE>(n0 + (lane & 31));
#pragma unroll
    for (int i = 0; i < 32; ++i) { const int kk = 2 * i + (lane >> 5); scr[kk * 33 + (lane & 31)] = W[(size_t)(k0 + kk) * ldw + oc]; }
    asm volatile("s_waitcnt lgkmcnt(0)" ::: "memory");
    const int c = lane & 7;
#pragma unroll
    for (int j = 0; j < 4; ++j) { const int n = (lane >> 3) + 8 * j; const LAS float* s = scr + (8 * c) * 33 + n;
        v4u o; o.x = pk2(s[0 * 33], s[1 * 33]); o.y = pk2(s[2 * 33], s[3 * 33]); o.z = pk2(s[4 * 33], s[5 * 33]); o.w = pk2(s[6 * 33], s[7 * 33]);
        *(v4u*)(WT + (size_t)(n0 + n) * K + k0 + 8 * c) = o; }
    asm volatile("s_waitcnt lgkmcnt(0)" ::: "memory");
}

#define XB_TMO      128
#define XB_XCNT(j)  (256  + 64 * (j))
#define XB_XSUB(j)  (1280 + 64 * (j))
#define XB_XGEN(j)  (2304 + 64 * (j))
#define XB_TOP      3328
#define XB_TOPGEN   3392
#define XCD_BAR_WORDS 3456
#define XB_SPIN_CAP (1u << 18)

__device__ __forceinline__ unsigned xb_ld(unsigned* p)              { return __hip_atomic_load(p, __ATOMIC_RELAXED, __HIP_MEMORY_SCOPE_AGENT); }
__device__ __forceinline__ unsigned xb_add(unsigned* p, unsigned v) { return __hip_atomic_fetch_add(p, v, __ATOMIC_RELAXED, __HIP_MEMORY_SCOPE_AGENT); }
__device__ __forceinline__ unsigned xb_xcc_id() { return (unsigned)__builtin_amdgcn_s_getreg((3 << 11) | 20) & 0xFu; }
#define XB_SPIN(cond, bar) do { unsigned _sp = 0; while (cond) { __builtin_amdgcn_s_sleep(1); \
    if ((++_sp & 255u) == 0u) { if (xb_ld(&(bar)[XB_TMO])) break; if (_sp > XB_SPIN_CAP) { atomicAdd(&(bar)[XB_TMO], 1u); break; } } } } while (0)

struct XcdBarrier {
    unsigned* bar; unsigned x;
    volatile LAS unsigned* st;
};

__device__ __forceinline__ XcdBarrier xcd_barrier_post(unsigned* bar, volatile LAS unsigned* st) {
    XcdBarrier b; b.bar = bar; b.x = xb_xcc_id(); b.st = st;
    if (threadIdx.x == 0) (void)xb_add(&bar[XB_XCNT(b.x)], 1u);
    return b;
}
__device__ __forceinline__ void xcd_barrier_complete(unsigned* bar, unsigned x, unsigned& nloc, unsigned& nx) {
    const unsigned G = gridDim.x * gridDim.y * gridDim.z;
    unsigned sum, cnt, mine, sp = 0u;
    for (;;) {
        sum = 0u; cnt = 0u; mine = 0u;
#pragma unroll
        for (unsigned j = 0; j < 16; ++j) { const unsigned c = xb_ld(&bar[XB_XCNT(j)]); sum += c; cnt += (c > 0u) ? 1u : 0u; mine = (j == x) ? c : mine; }
        if (sum == G) break;
        __builtin_amdgcn_s_sleep(1);
        if ((++sp & 255u) == 0u) { if (xb_ld(&bar[XB_TMO])) break; if (sp > XB_SPIN_CAP) { atomicAdd(&bar[XB_TMO], 1u); break; } }
    }
    nloc = mine > 0u ? mine : 1u; nx = cnt > 0u ? cnt : 1u;
}

__device__ __forceinline__ void xcd_barrier(const XcdBarrier& b) {
    asm volatile("s_waitcnt vmcnt(0)" ::: "memory");
    __syncthreads();
    if (threadIdx.x == 0) {
        unsigned* bar = b.bar;
        __builtin_amdgcn_s_waitcnt(0);
        unsigned nloc = b.st[0], nx = b.st[1];
        if (nloc == 0u) { xcd_barrier_complete(bar, b.x, nloc, nx); b.st[0] = nloc; b.st[1] = nx; }
        const unsigned old = xb_add(&bar[XB_XSUB(b.x)], 1u);
        const unsigned gen = old / nloc;
        if (old + 1u == (gen + 1u) * nloc) {
            __builtin_amdgcn_fence(__ATOMIC_RELEASE, "agent");
            asm volatile("s_waitcnt vmcnt(0)" ::: "memory");
            const unsigned og = xb_add(&bar[XB_TOP], 1u);
            const unsigned tg = og / nx;
            if (og + 1u == (tg + 1u) * nx) xb_add(&bar[XB_TOPGEN], 1u);
            else XB_SPIN(xb_ld(&bar[XB_TOPGEN]) == tg, bar);
            __builtin_amdgcn_fence(__ATOMIC_ACQUIRE, "agent");
            xb_add(&bar[XB_XGEN(b.x)], 1u);
            asm volatile("s_waitcnt vmcnt(0)" ::: "memory");
        } else {
            XB_SPIN(xb_ld(&bar[XB_XGEN(b.x)]) == gen, bar);
            __builtin_amdgcn_fence(__ATOMIC_ACQUIRE, "agent");
            asm volatile("s_waitcnt vmcnt(0)" ::: "memory");
        }
    }
    __syncthreads();
}

struct Args { const void* in[17]; float* out; unsigned char* ws; };

__global__ void __launch_bounds__(NTHR, 2) fwd_megakernel(Args a) {
    extern __shared__ __attribute__((aligned(16))) unsigned char lds[];
    cg::grid_group grid = cg::this_grid();
    LAS unsigned char* ldsl = (LAS unsigned char*)lds;
    const int G = gridDim.x, bx = blockIdx.x;
    const int vcu = (G % 8 == 0) ? (bx % 8) * (G / 8) + bx / 8 : bx;
    const int NGW = G * NWAVES;
    unsigned char* ws = a.ws;
    const float* x_in = (const float*)a.in[0]; const int* positions = (const int*)a.in[1];
    float* LOGF = (float*)(ws + WS_LOGF); float* CNEG = (float*)(ws + WS_CNEG); float* CS = (float*)(ws + WS_CS);
    bf16r* W1t = (bf16r*)(ws + WS_W1); bf16r* Wmgt = (bf16r*)(ws + WS_WMG); bf16r* Wbrt = (bf16r*)(ws + WS_WBR); bf16r* Wot = (bf16r*)(ws + WS_WO);
    bf16r* H = (bf16r*)(ws + WS_H); bf16r* OD = (bf16r*)(ws + WS_OD); bf16r* P = (bf16r*)(ws + WS_P); bf16r* O16 = (bf16r*)(ws + WS_P);
    float* out = a.out;
    volatile LAS unsigned* misc = (volatile LAS unsigned*)(ldsl + LDS_MISC);
    if (threadIdx.x < 64) misc[threadIdx.x] = 0u;
    __syncthreads();
    XcdBarrier xbar = xcd_barrier_post((unsigned*)(ws + WS_CTL), misc);
    bool first_sync = true;
#define GSYNC() do { if (first_sync) { grid.sync(); first_sync = false; } else xcd_barrier(xbar); } while (0)
#ifdef PROBE_K
    unsigned long long ts_prev = __builtin_amdgcn_s_memrealtime(); float ts_acc = 0.f;
#define STAMP(k) do { const unsigned long long t_ = __builtin_amdgcn_s_memrealtime(); if ((k) == PROBE_K) ts_acc += (float)(t_ - ts_prev); \
        if ((k) == 5 && PROBE_K == 6) { GSYNC(); const unsigned long long t2_ = __builtin_amdgcn_s_memrealtime(); ts_acc += (float)(t2_ - t_); ts_prev = t2_; } else ts_prev = t_; } while (0)
#else
#define STAMP(k) do {} while (0)
#endif

#pragma unroll 1
    for (int l = 0; l <= DEPTH; ++l) {
        const bool fin = (l == DEPTH);
        for (int rep_ = 0; rep_ < (fin ? 1 : REP_A); ++rep_) {
        if (!fin && (PHM & 1)) {
            int tid = threadIdx.x; asm volatile("" : "+v"(tid)); const int lane = tid & 63, wave = __builtin_amdgcn_readfirstlane(tid >> 6), gw = bx * NWAVES + wave; (void)lane; (void)gw;
            LAS float* scr = (LAS float*)(ldsl + 32768 + wave * 8704);
            const float* win = (const float*)a.in[3] + (size_t)l * DM * INW;
            const float* wbf = (const float*)a.in[12] + (size_t)l * 512 * DM; const float* wbd = (const float*)a.in[13] + (size_t)l * 512 * DM;
            const float* wbc = (const float*)a.in[14] + (size_t)l * 512 * DM; const float* wo = (const float*)a.in[15] + (size_t)l * DM * DM;
            constexpr int I_1 = 16 * 192, I_G = 16 * 96, I_B = 8 * 32, I_O = 16 * 32, NITEMS = I_1 + I_G + 3 * I_B + I_O;
            for (int repw_ = 0; repw_ < REP_W; ++repw_)
            for (int it = gw; it < NITEMS; it += NGW) {
                int r = it;
                if (r < I_1) { transpose_item<1>(win, INW, DM, PW, W1t, scr, r, lane); continue; } r -= I_1;
                if (r < I_G) { transpose_item<2>(win, INW, DM, NMG, Wmgt, scr, r, lane); continue; } r -= I_G;
                if (r < I_B) { transpose_item<0>(wbf, DM, 512, DM, Wbrt, scr, r, lane); continue; } r -= I_B;
                if (r < I_B) { transpose_item<0>(wbd, DM, 512, DM, Wbrt + 512 * DM, scr, r, lane); continue; } r -= I_B;
                if (r < I_B) { transpose_item<0>(wbc, DM, 512, DM, Wbrt + 2 * 512 * DM, scr, r, lane); continue; } r -= I_B;
                transpose_item<0>(wo, DM, DM, DM, Wot, scr, r, lane);
            }
        }
        if (PHM & 2) {
            int tid = threadIdx.x; asm volatile("" : "+v"(tid)); const int lane = tid & 63, wave = __builtin_amdgcn_readfirstlane(tid >> 6), gw = bx * NWAVES + wave; (void)lane; (void)gw;
            LAS float* wff = (LAS float*)ldsl;
            if (!fin) { const float* win = (const float*)a.in[3] + (size_t)l * DM * INW;
                for (int i = tid; i < 8192; i += NTHR) { const int k = i >> 3, hh = i & 7; wff[hh * 1024 + k] = win[(size_t)k * INW + 1536 + hh]; } }
            __syncthreads();
            const float* xin = (l <= 1) ? x_in : out;
            const f32x4* postg = (const f32x4*)((const float*)a.in[16] + (size_t)(l > 0 ? l - 1 : 0) * DM);
            const f32x4* preg = (const f32x4*)((const float*)a.in[2] + (size_t)(fin ? 0 : l) * DM);
            const float* bfg = (const float*)a.in[4] + (fin ? 0 : l) * 8;
            for (int row0 = gw; row0 < T; row0 += 2 * NGW) {
                f32x4 v[2][4]; int rows[2]; bool ok[2];
#pragma unroll
                for (int q = 0; q < 2; ++q) { rows[q] = row0 + q * NGW; ok[q] = rows[q] < T; if (!ok[q]) rows[q] = row0;
                    const f32x4* xr = (const f32x4*)(xin + (size_t)rows[q] * DM) + lane;
#pragma unroll
                    for (int j = 0; j < 4; ++j) v[q][j] = xr[64 * j]; }
                if (l > 0) {
                    f32x4 ov[2][4]; float ss[2];
#pragma unroll
                    for (int q = 0; q < 2; ++q) { const uint2* orw = (const uint2*)(O16 + (size_t)rows[q] * DM) + lane; ss[q] = 0.f;
#pragma unroll
                        for (int j = 0; j < 4; ++j) { const uint2 w_ = orw[64 * j]; ov[q][j] = (f32x4){pg8::bf_lo(w_.x), pg8::bf_hi(w_.x), pg8::bf_lo(w_.y), pg8::bf_hi(w_.y)}; ss[q] += (ov[q][j].x * ov[q][j].x + ov[q][j].y * ov[q][j].y) + (ov[q][j].z * ov[q][j].z + ov[q][j].w * ov[q][j].w); } }
#pragma unroll
                    for (int o = 1; o < 64; o <<= 1) { ss[0] += __shfl_xor(ss[0], o); ss[1] += __shfl_xor(ss[1], o); }
#pragma unroll
                    for (int q = 0; q < 2; ++q) { const float rs = rsqrtf(ss[q] * (1.f / DM) + RMS_EPS);
                        f32x4* xo = (f32x4*)(out + (size_t)rows[q] * DM) + lane;
#pragma unroll
                        for (int j = 0; j < 4; ++j) { v[q][j] = v[q][j] + ov[q][j] * rs * postg[lane + 64 * j]; if (ok[q]) xo[64 * j] = v[q][j]; } }
                }
                if (!fin) {
                    float ss[2];
#pragma unroll
                    for (int q = 0; q < 2; ++q) { ss[q] = 0.f;
#pragma unroll
                        for (int j = 0; j < 4; ++j) ss[q] += (v[q][j].x * v[q][j].x + v[q][j].y * v[q][j].y) + (v[q][j].z * v[q][j].z + v[q][j].w * v[q][j].w); }
#pragma unroll
                    for (int o = 1; o < 64; o <<= 1) { ss[0] += __shfl_xor(ss[0], o); ss[1] += __shfl_xor(ss[1], o); }
                    float f[2];
#pragma unroll
                    for (int q = 0; q < 2; ++q) { const float rs = rsqrtf(ss[q] * (1.f / DM) + RMS_EPS);
                        unsigned long long* o8 = (unsigned long long*)(H + (size_t)rows[q] * DM) + lane;
#pragma unroll
                        for (int j = 0; j < 4; ++j) { v[q][j] = v[q][j] * rs * preg[lane + 64 * j];
                            if (ok[q]) o8[64 * j] = (unsigned long long)pk2(v[q][j].x, v[q][j].y) | ((unsigned long long)pk2(v[q][j].z, v[q][j].w) << 32); }
                        float d[8];
#pragma unroll
                        for (int hh = 0; hh < 8; ++hh) { float s_ = 0.f;
#pragma unroll
                            for (int j = 0; j < 4; ++j) { const f32x4 w = *(const LAS f32x4*)(wff + hh * 1024 + 4 * lane + 256 * j); s_ += (v[q][j].x * w.x + v[q][j].y * w.y) + (v[q][j].z * w.z + v[q][j].w * w.w); }
                            d[hh] = s_; }
                        float a4[4], c2[2];
                        const bool h5 = (lane & 32) != 0, h4 = (lane & 16) != 0, h3 = (lane & 8) != 0;
#pragma unroll
                        for (int i = 0; i < 4; ++i) { const float keep = h5 ? d[i + 4] : d[i], give = h5 ? d[i] : d[i + 4]; a4[i] = keep + __shfl_xor(give, 32); }
#pragma unroll
                        for (int i = 0; i < 2; ++i) { const float keep = h4 ? a4[i + 2] : a4[i], give = h4 ? a4[i] : a4[i + 2]; c2[i] = keep + __shfl_xor(give, 16); }
                        { const float keep = h3 ? c2[1] : c2[0], give = h3 ? c2[0] : c2[1]; f[q] = keep + __shfl_xor(give, 8); }
                        f[q] += __shfl_xor(f[q], 4); f[q] += __shfl_xor(f[q], 2); f[q] += __shfl_xor(f[q], 1);
                    }
#pragma unroll
                    for (int q = 0; q < 2; ++q) if (ok[q]) {
                        const int i = lane >> 3;
                        if ((lane & 7) == 0) { const float z = f[q] + bfg[i];
                            LOGF[(size_t)rows[q] * 8 + i] = fminf(z, 0.f) - log1pf(expf(-fabsf(z)));
                        } else if (l == 0 && (lane & 7) == 1) {
                            float invf = 1.0f;
                            invf = (i == 1) ? 0.19392274f : invf; invf = (i == 2) ? 0.03760603f : invf; invf = (i == 3) ? 0.0072926646f : invf; invf = (i == 4) ? 0.0014142136f : invf;
                            invf = (i == 5) ? 0.0002742482f : invf; invf = (i == 6) ? 5.3182957e-05f : invf; invf = (i == 7) ? 1.0313385e-05f : invf;
                            const float ang = (float)positions[rows[q]] * invf;
                            const float n = rintf(ang * 0.15915494309189535f);
                            float r = fmaf(-n, 6.2831854820251465f, ang); r = fmaf(-n, -1.7484555e-7f, r);
                            CS[(size_t)rows[q] * 16 + i] = __cosf(r); CS[(size_t)rows[q] * 16 + 8 + i] = __sinf(r);
                        }
                    }
                }
            }
        }
        __syncthreads();
        }
        if (fin) break;
        GSYNC();
        STAMP(0);
        if (PHM & 4) {
            int tid = threadIdx.x; asm volatile("" : "+v"(tid)); const int lane = tid & 63, wave = __builtin_amdgcn_readfirstlane(tid >> 6), gw = bx * NWAVES + wave; (void)lane; (void)gw;
            LAS float* sc = (LAS float*)ldsl;
            for (int bh = bx; bh < NB * 8; bh += G) {
                const int b = bh >> 3, hh = bh & 7; const int t0 = tid * 8;
                float v[8]; float run = 0.f;
#pragma unroll
                for (int e = 0; e < 8; ++e) { run += LOGF[((size_t)b * SEQ + t0 + e) * 8 + hh]; v[e] = run; }
                float incl = run;
#pragma unroll
                for (int o = 1; o < 64; o <<= 1) { const float n = __shfl_up(incl, o); if (lane >= o) incl += n; }
                if (lane == 63) sc[wave] = incl;
                __syncthreads();
                float base = incl - run;
                for (int w = 0; w < wave; ++w) base += sc[w];
                float* cn = CNEG + (size_t)bh * SEQ + t0;
#pragma unroll
                for (int e = 0; e < 8; ++e) cn[e] = -(base + v[e]) * 1.4426950408889634f;
                __syncthreads();
            }
            pg8::Gemm g{H, W1t, DM, DM, 0, 0}; pg8::StaticOrder S; S.init(T, PW, G, bx);
            pg8::EpiProj E{P, CS};
            for (int rep_ = 0; rep_ < REP_B; ++rep_) pg8::gemm_phase<pg8::EpiProj, pg8::StaticOrder, true, true>(ldsl, g, S, E);
        }
        GSYNC();
        STAMP(1);
        if (PHM & 8) {
            int tid = threadIdx.x; asm volatile("" : "+v"(tid)); const int lane = tid & 63, wave = __builtin_amdgcn_readfirstlane(tid >> 6), gw = bx * NWAVES + wave; (void)lane; (void)gw;
            const float* cw = (const float*)a.in[6] + (size_t)l * 3 * 512;
            for (int repx_ = (l == 0 ? REP_X : 1) - 1; repx_ >= 0; --repx_)
#pragma unroll 2
            for (int it = bx * NTHR + tid; it < T * 64; it += G * NTHR) {
                const int t = it >> 6, c8 = (it & 63) * 8, s = t & (SEQ - 1);
                bf16r* pr = P + (size_t)t * PW;
                const v4u cb = *(const v4u*)(pr + 4096 + c8), cg_ = *(const v4u*)(pr + 5632 + c8);
                const v4u zero = (v4u){0u, 0u, 0u, 0u};
                const v4u c0 = *(const v4u*)(pr + 4608 + c8), x0 = *(const v4u*)(pr + 5120 + c8);
                const v4u c1 = s >= 1 ? *(const v4u*)(pr - PW + 4608 + c8) : zero, x1 = s >= 1 ? *(const v4u*)(pr - PW + 5120 + c8) : zero;
                const v4u c2 = s >= 2 ? *(const v4u*)(pr - 2 * PW + 4608 + c8) : zero, x2 = s >= 2 ? *(const v4u*)(pr - 2 * PW + 5120 + c8) : zero;
                float k0[8], k1[8], k2[8];
#pragma unroll
                for (int q = 0; q < 2; ++q) { const f32x4 wa = *(const f32x4*)(cw + c8 + 4 * q), wb = *(const f32x4*)(cw + 512 + c8 + 4 * q), wc_ = *(const f32x4*)(cw + 1024 + c8 + 4 * q);
                    k0[4 * q] = wa.x; k0[4 * q + 1] = wa.y; k0[4 * q + 2] = wa.z; k0[4 * q + 3] = wa.w; k1[4 * q] = wb.x; k1[4 * q + 1] = wb.y; k1[4 * q + 2] = wb.z; k1[4 * q + 3] = wb.w;
                    k2[4 * q] = wc_.x; k2[4 * q + 1] = wc_.y; k2[4 * q + 2] = wc_.z; k2[4 * q + 3] = wc_.w; }
                v4u o;
#pragma unroll
                for (int e = 0; e < 4; ++e) {
                    const float ul0 = pg8::bf_lo(c0[e]) * pg8::bf_lo(x0[e]), uh0 = pg8::bf_hi(c0[e]) * pg8::bf_hi(x0[e]);
                    const float ul1 = pg8::bf_lo(c1[e]) * pg8::bf_lo(x1[e]), uh1 = pg8::bf_hi(c1[e]) * pg8::bf_hi(x1[e]);
                    const float ul2 = pg8::bf_lo(c2[e]) * pg8::bf_lo(x2[e]), uh2 = pg8::bf_hi(c2[e]) * pg8::bf_hi(x2[e]);
                    const float yl = pg8::bf_lo(cb[e]) * (k0[2 * e] * ul2 + k1[2 * e] * ul1 + k2[2 * e] * ul0) * silu_f(pg8::bf_lo(cg_[e]));
                    const float yh = pg8::bf_hi(cb[e]) * (k0[2 * e + 1] * uh2 + k1[2 * e + 1] * uh1 + k2[2 * e + 1] * uh0) * silu_f(pg8::bf_hi(cg_[e]));
                    o[e] = pk2(yl, yh);
                }
                if (repx_ > 0) *(v4u*)((bf16r*)out + (size_t)t * 512 + c8) = o; else *(v4u*)(pr + 4096 + c8) = o;
            }
            asm volatile("s_waitcnt vmcnt(0)" ::: "memory"); __syncthreads();
            const int NPAIR = NB * 16 * 8, PPW = (NPAIR + G - 1) / G;
            for (int rep_ = (l == 0 ? REP_C : 1) - 1; rep_ >= 0; --rep_)
            for (int pj = 0; pj < PPW; ++pj) {
                int b, u, s;
                if (G == 256) { const int j = vcu >> 5, w = vcu & 31; b = j >> 1; u = pj * 8 + (j & 1) * 4 + (w >> 3); s = w & 7; }
                else { const int pi = vcu * PPW + pj; if (pi >= NPAIR) break; const int bhu = pi >> 3; s = pi & 7; b = bhu >> 4; u = bhu & 15; }
                const attn_body::bf16* Pb = (const attn_body::bf16*)(P + (size_t)b * SEQ * PW);
                if (u < 8) {
                    const attn_body::bf16 *Qp = Pb + u * 64, *Kp = Pb + 512 + u * 64, *Vp = Pb + 1024 + u * 64; attn_body::bf16* Op = (attn_body::bf16*)Qp; int ldo = PW;
                    const float* bias = CNEG + (size_t)(b * 8 + u) * SEQ;
                    if (rep_ > 0) { Op = (attn_body::bf16*)out + (size_t)b * SEQ * 512 + u * 64; ldo = 512; }
#pragma unroll 1
                    for (int k = 0; k < 2; ++k) attn_body::attn_unit<8, true, false>(k ? 15 - s : s, Qp, Kp, Vp, Op, PW, ldo, bias, Pb + 1536 + u * 64, (char*)lds);
                } else {
                    const int d = u - 8, h = d >> 1, c = d & 1;
                    const attn_body::bf16 *Qp = Pb + 2048 + h * 128 + c * 64, *Kp = Pb + 2560 + h * 128 + c * 64, *Vp = Pb + 3072 + h * 128;
                    attn_body::bf16* Op = (attn_body::bf16*)(OD + (size_t)b * SEQ * DM) + c * 512 + h * 128;
#pragma unroll 1
                    for (int k = 0; k < 2; ++k) attn_body::attn_unit<8, false, true>(k ? 15 - s : s, Qp, Kp, Vp, Op, PW, DM, nullptr, nullptr, (char*)lds);
                }
            }
        }
        GSYNC();
        STAMP(2);
        if (PHM & 16) {
            int tid = threadIdx.x; asm volatile("" : "+v"(tid)); const int lane = tid & 63, wave = __builtin_amdgcn_readfirstlane(tid >> 6), gw = bx * NWAVES + wave; (void)lane; (void)gw;
            for (int repy_ = (l == 0 ? REP_Y : 1) - 1; repy_ >= 0; --repy_) {
            const float lam_init = 0.8f - 0.6f * expf(-0.3f * (float)l);
            const float p1 = ((const float*)a.in[7])[l * 64 + lane] * ((const float*)a.in[8])[l * 64 + lane], p2 = ((const float*)a.in[9])[l * 64 + lane] * ((const float*)a.in[10])[l * 64 + lane];
            const float lam = expf(wave_sum(p1)) - expf(wave_sum(p2)) + lam_init;
            const float* dgn = (const float*)a.in[11] + (size_t)l * 128;
            const int j0 = (lane & 15) * 8;
            const f32x4 ga = *(const f32x4*)(dgn + j0), gb = *(const f32x4*)(dgn + j0 + 4); const float gg[8] = {ga.x, ga.y, ga.z, ga.w, gb.x, gb.y, gb.z, gb.w};
#pragma unroll 4
            for (int it = gw; it < T; it += NGW) {
                const int t = it, h = lane >> 4; bf16r* pr = P + (size_t)t * PW; const bf16r* od = OD + (size_t)t * DM;
                const v4u o0 = *(const v4u*)(od + h * 128 + j0), o1 = *(const v4u*)(od + 512 + h * 128 + j0), dg = *(const v4u*)(pr + 3584 + h * 128 + j0);
                float dv[8]; float ss = 0.f;
#pragma unroll
                for (int e = 0; e < 4; ++e) { dv[2 * e] = pg8::bf_lo(o0[e]) - lam * pg8::bf_lo(o1[e]); dv[2 * e + 1] = pg8::bf_hi(o0[e]) - lam * pg8::bf_hi(o1[e]); ss += dv[2 * e] * dv[2 * e] + dv[2 * e + 1] * dv[2 * e + 1]; }
                ss += __shfl_xor(ss, 1); ss += __shfl_xor(ss, 2); ss += __shfl_xor(ss, 4); ss += __shfl_xor(ss, 8);
                const float rs = rsqrtf(ss * (1.f / 128.f) + RMS_EPS) * (1.f - lam_init);
                v4u o;
#pragma unroll
                for (int e = 0; e < 4; ++e) { const float g0 = gg[2 * e], g1 = gg[2 * e + 1];
                    o[e] = pk2(dv[2 * e] * rs * g0 * silu_f(pg8::bf_lo(dg[e])), dv[2 * e + 1] * rs * g1 * silu_f(pg8::bf_hi(dg[e]))); }
                if (repy_ > 0) *(v4u*)((bf16r*)out + (size_t)T * 512 + (size_t)t * 512 + h * 128 + j0) = o; else *(v4u*)(pr + 2048 + h * 128 + j0) = o;
            }
            }
            asm volatile("s_waitcnt vmcnt(0)" ::: "memory"); __syncthreads();
            pg8::Gemm g{H, Wmgt, DM, DM, 0, 0}; pg8::StaticOrder S; S.init(T, NMG, G, bx);
            pg8::EpiGate E{P, (const float*)a.in[5] + (size_t)l * NMG};
            for (int rep_ = 0; rep_ < REP_G; ++rep_) pg8::gemm_phase<pg8::EpiGate, pg8::StaticOrder, true, true>(ldsl, g, S, E);
        }
        GSYNC();
        STAMP(3);
        if (PHM & 32) {
            pg8::Gemm g{P, Wbrt, PW, 512, 2048, (size_t)512 * DM}; pg8::MergeOrder S; S.init(T, DM, G, bx);
            pg8::EpiMerge E{P, H};
            for (int rep_ = 0; rep_ < REP_D; ++rep_) pg8::gemm_phase<pg8::EpiMerge, pg8::MergeOrder, true, true>(ldsl, g, S, E);
        }
        GSYNC();
        STAMP(4);
        if (PHM & 64) {
            pg8::Gemm g{H, Wot, DM, DM, 0, 0}; pg8::StaticOrder S; S.init(T, DM, G, bx);
            pg8::EpiF32 E{O16};
            for (int rep_ = 0; rep_ < REP_E; ++rep_) pg8::gemm_phase<pg8::EpiF32, pg8::StaticOrder, true, true>(ldsl, g, S, E);
        }
        GSYNC();
        for (int rep_ = 0; rep_ < REP_S; ++rep_) GSYNC();
        STAMP(5);
    }
#ifdef PROBE_K
    GSYNC();
    if (bx == 0 && threadIdx.x == 0) out[0] = ts_acc * 0.1f;
#endif
#undef GSYNC
}

extern "C" void kernel_launch(void* const* d_in, const int* in_sizes, int n_in, void* d_out, int out_size, void* d_ws, size_t ws_size, hipStream_t stream) {
    static int grid = 0;
    if (grid == 0) {
        if (n_in != 17 || out_size != T * DM || ws_size < WS_END) { fprintf(stderr, "kernel_launch: unexpected shapes / workspace (n_in %d, out %d, ws %zu < %zu)\n", n_in, out_size, ws_size, (size_t)WS_END); grid = -1; return; }
        int dev = 0, cus = 0, per_cu = 0;
        hipGetDevice(&dev); hipDeviceGetAttribute(&cus, hipDeviceAttributeMultiprocessorCount, dev);
        hipFuncSetAttribute((const void*)fwd_megakernel, hipFuncAttributeMaxDynamicSharedMemorySize, LDS_BYTES);
        if (hipOccupancyMaxActiveBlocksPerMultiprocessor(&per_cu, (const void*)fwd_megakernel, NTHR, LDS_BYTES) != hipSuccess || per_cu < 1) per_cu = 1;
        (void)hipGetLastError();
        grid = cus * per_cu;
    }
    if (grid < 0) return;
    (void)hipMemsetAsync((char*)d_ws + WS_CTL, 0, CTL_BYTES, stream);
    Args a{};
    for (int i = 0; i < 17; ++i) a.in[i] = d_in[i];
    a.out = (float*)d_out; a.ws = (unsigned char*)d_ws;
    void* args[] = {&a};
    hipError_t e = hipLaunchCooperativeKernel((const void*)fwd_megakernel, dim3(grid), dim3(NTHR), args, LDS_BYTES, stream);
    if (e != hipSuccess) fprintf(stderr, "cooperative launch failed: %s (grid %d)\n", hipGetErrorString(e), grid);
}
```

```cpp
#include <hip/hip_runtime.h>
#include <cstdio>
#include <cstdint>
namespace pg8 {
#define PG8_LAS __attribute__((address_space(3)))
typedef unsigned short bf16_t;
typedef short bf16x8 __attribute__((ext_vector_type(8)));
typedef float f32x4 __attribute__((ext_vector_type(4)));
typedef unsigned u32x4 __attribute__((ext_vector_type(4)));
constexpr int BM = 256, BK = 64, HALF = 128, HTB = HALF * BK * 2  , STAGE_BYTES = 8 * HTB, NXCD = 8;

__host__ __device__ __forceinline__ int lds_byte(int r, int c) { const int st = (r >> 4) * 2 + (c >> 5), rr = r & 15, cc = c & 31, ob = rr * 64 + cc * 2; return st * 1024 + (ob ^ (((ob >> 9) & 1) << 5)); }
__host__ __device__ __forceinline__ void stage_rc(int b, int& R, int& C) { const int st = b / 1024, sb = b % 1024, swz = sb ^ (((sb >> 9) & 1) << 5); R = (st >> 1) * 16 + swz / 64; C = (st & 1) * 32 + (swz % 64) / 2; }
__host__ __device__ __forceinline__ int perm32(int rho) { const int n = rho >> 4, i = rho & 15; return 8 * (i >> 2) + 4 * n + (i & 3); }

struct Unit { int pm, pn, z; };
struct Gemm { const bf16_t* A; const bf16_t* Bt; int lda, K; size_t Az, Bz; };

struct StaticOrder {
    int nM, nN, nwg, G, c, WGM;
    __host__ __device__ void init(int M, int N, int G_, int c_, int wgm = 2) { nM = M / BM; nN = N / BM; nwg = nM * nN; G = G_; c = c_; WGM = wgm; }
    __host__ __device__ bool next(int i, Unit& u) const {
        const long L = (long)i * G + c; if (L >= nwg) return false;
        int wgid = (int)L; { const int q = nwg / NXCD, r = nwg % NXCD, xcd = wgid % NXCD, off = wgid / NXCD; wgid = (xcd < r ? xcd * (q + 1) : r * (q + 1) + (xcd - r) * q) + off; }
        const int nig = WGM * nN, gid = wgid / nig, fm = gid * WGM, gsz = (nM - fm) < WGM ? (nM - fm) : WGM;
        u.pm = fm + ((wgid % nig) % gsz); u.pn = (wgid % nig) / gsz; u.z = 0; return true;
    }
    __device__ __forceinline__ void a_ready(const Unit&) const {}
    __device__ __forceinline__ void done(const Unit&) const {}
};

__device__ __forceinline__ unsigned cvt_pk_bf16(float lo, float hi) { unsigned r; asm volatile("v_cvt_pk_bf16_f32 %0, %1, %2" : "=v"(r) : "v"(lo), "v"(hi)); return r; }
typedef float f32x2 __attribute__((ext_vector_type(2)));
constexpr int PW = 6144;
constexpr float QC2 = 0.125f * 1.4426950408889634f;
__device__ __forceinline__ float bf_lo(unsigned w) { return __uint_as_float(w << 16); }
__device__ __forceinline__ float bf_hi(unsigned w) { return __uint_as_float(w & 0xffff0000u); }

struct EpiProj {
    static constexpr bool PERM = true, AFTER_DRAIN = false;
    bf16_t* O; const float* cs;
    __device__ __forceinline__ bool operator()(f32x4 (&acc)[2][2][4][2], const Unit& u, int wr, int wc, int fr, int fq) const {
        const int row0 = u.pm * BM + wr * 64 + fr; const int col0 = u.pn * BM + wc * 32 + 8 * fq; const int pn = u.pn;
        const bool rot = (pn >= 8 && pn < 12) && ((wc & 1) == 0) && (fq < 2);
        const float sc = (pn < 2 || pn == 8 || pn == 9) ? QC2 : 1.f;
#pragma unroll
        for (int ai = 0; ai < 2; ++ai)
#pragma unroll
            for (int m = 0; m < 4; ++m) { const int row = row0 + ai * HALF + m * 16; bf16_t* rowp = O + (size_t)row * PW + col0;
                f32x4 c4 = (f32x4){1.f, 1.f, 1.f, 1.f}, s4 = (f32x4){0.f, 0.f, 0.f, 0.f};
                if (rot) { c4 = *(const f32x4*)(cs + (size_t)row * 16 + 4 * fq); s4 = *(const f32x4*)(cs + (size_t)row * 16 + 8 + 4 * fq); }
#pragma unroll
                for (int bj = 0; bj < 2; ++bj) { f32x4 v0 = acc[ai][bj][m][0], v1 = acc[ai][bj][m][1];
                    if (rot) { f32x4 a, b;
                        a[0] = v0[0] * c4[0] - v0[1] * s4[0]; a[1] = v0[1] * c4[0] + v0[0] * s4[0]; a[2] = v0[2] * c4[1] - v0[3] * s4[1]; a[3] = v0[3] * c4[1] + v0[2] * s4[1];
                        b[0] = v1[0] * c4[2] - v1[1] * s4[2]; b[1] = v1[1] * c4[2] + v1[0] * s4[2]; b[2] = v1[2] * c4[3] - v1[3] * s4[3]; b[3] = v1[3] * c4[3] + v1[2] * s4[3];
                        v0 = a; v1 = b; }
                    v0 = v0 * sc; v1 = v1 * sc; u32x4 w; w.x = cvt_pk_bf16(v0[0], v0[1]); w.y = cvt_pk_bf16(v0[2], v0[3]); w.z = cvt_pk_bf16(v1[0], v1[1]); w.w = cvt_pk_bf16(v1[2], v1[3]);
                    *(u32x4*)(rowp + bj * HALF) = w; }
                asm volatile("" ::: "memory"); }
        return false;
    }
};
struct EpiGate {
    static constexpr bool PERM = true, AFTER_DRAIN = false;
    bf16_t* O; const float* bias;
    __device__ __forceinline__ bool operator()(f32x4 (&acc)[2][2][4][2], const Unit& u, int wr, int wc, int fr, int fq) const {
        const int row0 = u.pm * BM + wr * 64 + fr; const int br = u.pn >> 2;
        const int col0 = 512 + br * 2048 + (u.pn & 3) * BM + wc * 32 + 8 * fq, bcol0 = u.pn * BM + wc * 32 + 8 * fq;
        f32x4 bv[2][2];
#pragma unroll
        for (int bj = 0; bj < 2; ++bj)
#pragma unroll
            for (int n = 0; n < 2; ++n) bv[bj][n] = *(const f32x4*)(bias + bcol0 + bj * HALF + 4 * n);
#pragma unroll
        for (int ai = 0; ai < 2; ++ai)
#pragma unroll
            for (int m = 0; m < 4; ++m) { bf16_t* rowp = O + (size_t)(row0 + ai * HALF + m * 16) * PW + col0;
#pragma unroll
                for (int bj = 0; bj < 2; ++bj) { const f32x4 v0 = acc[ai][bj][m][0] + bv[bj][0], v1 = acc[ai][bj][m][1] + bv[bj][1];
                    u32x4 w; w.x = cvt_pk_bf16(v0[0], v0[1]); w.y = cvt_pk_bf16(v0[2], v0[3]); w.z = cvt_pk_bf16(v1[0], v1[1]); w.w = cvt_pk_bf16(v1[2], v1[3]);
                    *(u32x4*)(rowp + bj * HALF) = w; }
                asm volatile("" ::: "memory"); }
        return false;
    }
};
struct EpiMerge {
    static constexpr bool PERM = true, AFTER_DRAIN = false;
    const bf16_t* Pg; bf16_t* Mo;
    __device__ __forceinline__ bool operator()(f32x4 (&acc)[2][2][4][2], const Unit& u, int wr, int wc, int fr, int fq) const {
        const int row0 = u.pm * BM + wr * 64 + fr; const int br = u.z;
        const int colg = 512 + br * 2048 + u.pn * BM + wc * 32 + 8 * fq, colm = u.pn * BM + wc * 32 + 8 * fq;
        const float L2E = 1.4426950408889634f;
#pragma unroll
        for (int ai = 0; ai < 2; ++ai)
#pragma unroll
            for (int m = 0; m < 4; ++m) { const size_t row = (size_t)(row0 + ai * HALF + m * 16);
#pragma unroll
                for (int bj = 0; bj < 2; ++bj) {
                    const u32x4 ga = *(const u32x4*)(Pg + row * PW + colg + bj * HALF);
                    u32x4 gb = (u32x4){0u, 0u, 0u, 0u}; if (br < 2) gb = *(const u32x4*)(Pg + row * PW + colg + 2048 + bj * HALF);
                    float f[8];
#pragma unroll
                    for (int e = 0; e < 4; ++e) { const unsigned wa = ga[e], wb = gb[e];
                        const float a0 = bf_lo(wa), a1 = bf_hi(wa), b0 = bf_lo(wb), b1 = bf_hi(wb);
                        const float ea0 = __builtin_amdgcn_exp2f(fminf(-a0 * L2E, 100.f)), ea1 = __builtin_amdgcn_exp2f(fminf(-a1 * L2E, 100.f));
                        float n0 = 1.f, n1 = 1.f; if (br < 2) { n0 = 1.f + __builtin_amdgcn_exp2f(fminf(-b0 * L2E, 100.f)); n1 = 1.f + __builtin_amdgcn_exp2f(fminf(-b1 * L2E, 100.f)); }
                        f[2 * e] = n0 * __builtin_amdgcn_rcpf(1.f + ea0); f[2 * e + 1] = n1 * __builtin_amdgcn_rcpf(1.f + ea1); }
                    f32x4 v0 = acc[ai][bj][m][0], v1 = acc[ai][bj][m][1];
                    v0[0] *= f[0]; v0[1] *= f[1]; v0[2] *= f[2]; v0[3] *= f[3]; v1[0] *= f[4]; v1[1] *= f[5]; v1[2] *= f[6]; v1[3] *= f[7];
                    acc[ai][bj][m][0] = v0; acc[ai][bj][m][1] = v1;
                    if (br == 2) { u32x4 w; w.x = cvt_pk_bf16(v0[0], v0[1]); w.y = cvt_pk_bf16(v0[2], v0[3]); w.z = cvt_pk_bf16(v1[0], v1[1]); w.w = cvt_pk_bf16(v1[2], v1[3]);
                        *(u32x4*)(Mo + row * 1024 + colm + bj * HALF) = w; } } }
        return br < 2;
    }
};
struct EpiF32 {
    static constexpr bool PERM = true, AFTER_DRAIN = false;
    bf16_t* O;
    __device__ __forceinline__ bool operator()(f32x4 (&acc)[2][2][4][2], const Unit& u, int wr, int wc, int fr, int fq) const {
        const int row0 = u.pm * BM + wr * 64 + fr; const int col0 = u.pn * BM + wc * 32 + 8 * fq;
#pragma unroll
        for (int ai = 0; ai < 2; ++ai)
#pragma unroll
            for (int m = 0; m < 4; ++m) { bf16_t* rowp = O + (size_t)(row0 + ai * HALF + m * 16) * 1024 + col0;
#pragma unroll
                for (int bj = 0; bj < 2; ++bj) { const f32x4 v0 = acc[ai][bj][m][0], v1 = acc[ai][bj][m][1];
                    u32x4 w; w.x = cvt_pk_bf16(v0[0], v0[1]); w.y = cvt_pk_bf16(v0[2], v0[3]); w.z = cvt_pk_bf16(v1[0], v1[1]); w.w = cvt_pk_bf16(v1[2], v1[3]);
                    *(u32x4*)(rowp + bj * HALF) = w; } }
        return false;
    }
};
struct MergeOrder {
    StaticOrder so;
    __host__ __device__ void init(int M, int N, int G_, int c_, int wgm = 2) { so.init(M, N, G_, c_, wgm); }
    __host__ __device__ bool next(int i, Unit& u) const { const int j = i / 3; if (!so.next(j, u)) return false; u.z = i - 3 * j; return true; }
    __device__ __forceinline__ void a_ready(const Unit&) const {}
    __device__ __forceinline__ void done(const Unit&) const {}
};


template <class Epi, class Sched, bool ALIGN_EPI = false, bool SP2 = false>
__device__ __forceinline__ void gemm_phase(PG8_LAS unsigned char* lds, const Gemm g, const Sched& S, const Epi& E) {
    int tid_ = threadIdx.x; asm volatile("" : "+v"(tid_));
    const int tid = tid_, wid = __builtin_amdgcn_readfirstlane(tid >> 6), lane = tid & 63, wr = wid >> 2, wc = wid & 3, fr = lane & 15, fq = lane >> 4;
    const int K = g.K, nt = K / BK;
    unsigned voffA[2], voffB[2];
#pragma unroll
    for (int i = 0; i < 2; ++i) { int R, C; stage_rc(tid * 16 + i * 8192, R, C); const int Rb = Epi::PERM ? ((R & ~31) + perm32(R & 31)) : R;
        voffA[i] = (unsigned)(R * g.lda + C) * 2u; voffB[i] = (unsigned)(Rb * K + C) * 2u; }
    const size_t kstep = (size_t)(BK * 2);
    const size_t hstepA = (size_t)HALF * g.lda * 2, hstepB = (size_t)HALF * K * 2;
    const size_t tstepA = 2 * hstepA, tstepB = 2 * hstepB;
    const unsigned ldsw = (unsigned)wid * 1024u;
    const int aoff = lds_byte(wr * 64 + fr, fq * 8), boff = lds_byte(wc * 32 + fr, fq * 8);
#define PG8_SA(b, h) (((b) * 2 + (h)) * HTB)
#define PG8_SB(b, h) ((4 + (b) * 2 + (h)) * HTB)
#define PG8_STAGE(bufoff, gbase, voff) do { _Pragma("unroll") for (int _i = 0; _i < 2; ++_i) \
        __builtin_amdgcn_global_load_lds((const unsigned*)((const char*)(gbase) + (voff)[_i]), (PG8_LAS unsigned*)(lds + (bufoff) + ldsw + _i * 8192), 16, 0, 0); } while (0)
#define PG8_LDA(dst, b, h) do { _Pragma("unroll") for (int m = 0; m < 4; ++m) _Pragma("unroll") for (int k = 0; k < 2; ++k) dst[m][k] = *(const PG8_LAS bf16x8*)(lds + PG8_SA(b, h) + aoff + m * 2048 + k * 1024); } while (0)
#define PG8_LDB(dst, b, h) do { _Pragma("unroll") for (int n = 0; n < 2; ++n) _Pragma("unroll") for (int k = 0; k < 2; ++k) dst[n][k] = *(const PG8_LAS bf16x8*)(lds + PG8_SB(b, h) + boff + n * 2048 + k * 1024); } while (0)
#define PG8_MMA(ai, bj, At, Bt) do { __builtin_amdgcn_s_setprio(1); _Pragma("unroll") for (int m = 0; m < 4; ++m) _Pragma("unroll") for (int n = 0; n < 2; ++n) _Pragma("unroll") for (int k = 0; k < 2; ++k) \
        acc[ai][bj][m][n] = __builtin_amdgcn_mfma_f32_16x16x32_bf16(Bt[n][k], At[m][k], acc[ai][bj][m][n], 0, 0, 0); __builtin_amdgcn_s_setprio(0); } while (0)
#define PG8_WAIT_V(n) asm volatile("s_waitcnt vmcnt(" #n ")" ::: "memory")
#define PG8_WAIT_L(n) asm volatile("s_waitcnt lgkmcnt(" #n ")" ::: "memory")
#define PG8_BAR __builtin_amdgcn_s_barrier()
#define PG8_SCHED __builtin_amdgcn_sched_barrier(0)
    Unit cur, nxt; int ui = 0;
    if (!S.next(0, cur)) return;
    f32x4 acc[2][2][4][2];
#pragma unroll
    for (int a = 0; a < 2; ++a)
#pragma unroll
        for (int b = 0; b < 2; ++b)
#pragma unroll
            for (int m = 0; m < 4; ++m)
#pragma unroll
                for (int n = 0; n < 2; ++n) acc[a][b][m][n] = (f32x4){0.f, 0.f, 0.f, 0.f};
    bf16x8 At[4][2], B0[2][2], B1[2][2];
    const char* cA = (const char*)(g.A + (size_t)cur.z * g.Az) + (size_t)cur.pm * tstepA; const char* cB = (const char*)(g.Bt + (size_t)cur.z * g.Bz) + (size_t)cur.pn * tstepB;
    S.a_ready(cur);
    if constexpr (SP2) {
        PG8_STAGE(PG8_SB(0, 0), cB, voffB); PG8_STAGE(PG8_SB(0, 1), cB + hstepB, voffB); PG8_STAGE(PG8_SA(0, 0), cA, voffA); PG8_STAGE(PG8_SA(0, 1), cA + hstepA, voffA);
        if (wr == 1) PG8_BAR;
        PG8_WAIT_V(2); PG8_BAR;
        PG8_STAGE(PG8_SB(1, 0), cB + kstep, voffB); PG8_STAGE(PG8_SA(1, 0), cA + kstep, voffA); PG8_STAGE(PG8_SB(1, 1), cB + hstepB + kstep, voffB);
        PG8_WAIT_V(6); PG8_BAR;
    } else {
        PG8_STAGE(PG8_SB(0, 0), cB, voffB); PG8_STAGE(PG8_SA(0, 0), cA, voffA); PG8_STAGE(PG8_SB(0, 1), cB + hstepB, voffB); PG8_STAGE(PG8_SA(0, 1), cA + hstepA, voffA);
        if (wr == 1) PG8_BAR;
        PG8_WAIT_V(4); PG8_BAR;
        PG8_STAGE(PG8_SB(1, 0), cB + kstep, voffB); PG8_STAGE(PG8_SA(1, 0), cA + kstep, voffA); PG8_STAGE(PG8_SB(1, 1), cB + hstepB + kstep, voffB);
        PG8_WAIT_V(6); PG8_BAR;
    }
    for (;;) {
        const bool has_next = S.next(ui + 1, nxt);
        const char* nA = has_next ? (const char*)(g.A + (size_t)nxt.z * g.Az) + (size_t)nxt.pm * tstepA : cA; const char* nB = has_next ? (const char*)(g.Bt + (size_t)nxt.z * g.Bz) + (size_t)nxt.pn * tstepB : cB;
        for (int t = 0; t < nt; t += 2) {
            const bool last = (t == nt - 2);
            const char* a1 = cA + (size_t)(t + 1) * kstep;
            const char* a2 = last ? nA : cA + (size_t)(t + 2) * kstep; const char* b2 = last ? nB : cB + (size_t)(t + 2) * kstep;
            const char* a3 = a2 + kstep; const char* b3 = b2 + kstep;
            if (last && has_next) S.a_ready(nxt);
            if constexpr (SP2) {
            PG8_LDB(B0, 0, 0); PG8_LDB(B1, 0, 1); PG8_SCHED; PG8_LDA(At, 0, 0); PG8_STAGE(PG8_SA(1, 1), a1 + hstepA, voffA);
            PG8_WAIT_V(8); PG8_WAIT_L(0); PG8_BAR; PG8_MMA(0, 0, At, B0); PG8_MMA(0, 1, At, B1); PG8_BAR; PG8_SCHED;
            PG8_LDA(At, 0, 1); PG8_STAGE(PG8_SB(0, 0), b2, voffB); PG8_STAGE(PG8_SB(0, 1), b2 + hstepB, voffB); PG8_STAGE(PG8_SA(0, 0), a2, voffA);
            PG8_WAIT_V(8); PG8_WAIT_L(0); PG8_BAR; PG8_MMA(1, 0, At, B0); PG8_MMA(1, 1, At, B1); PG8_BAR; PG8_SCHED;
            PG8_LDB(B0, 1, 0); PG8_LDB(B1, 1, 1); PG8_SCHED; PG8_LDA(At, 1, 0); PG8_STAGE(PG8_SA(0, 1), a2 + hstepA, voffA);
            PG8_WAIT_V(8); PG8_WAIT_L(0); PG8_BAR; PG8_MMA(0, 0, At, B0); PG8_MMA(0, 1, At, B1); PG8_BAR; PG8_SCHED;
            PG8_LDA(At, 1, 1); PG8_STAGE(PG8_SB(1, 0), b3, voffB); PG8_STAGE(PG8_SB(1, 1), b3 + hstepB, voffB); PG8_STAGE(PG8_SA(1, 0), a3, voffA);
            PG8_WAIT_V(8); PG8_WAIT_L(0); PG8_BAR; PG8_MMA(1, 0, At, B0); PG8_MMA(1, 1, At, B1); PG8_BAR; PG8_SCHED;
            } else {
            PG8_LDB(B0, 0, 0); PG8_SCHED; PG8_LDA(At, 0, 0); PG8_STAGE(PG8_SA(1, 1), a1 + hstepA, voffA);
            PG8_WAIT_L(8); PG8_BAR; PG8_WAIT_L(0); PG8_MMA(0, 0, At, B0); PG8_BAR; PG8_SCHED;
            PG8_LDB(B1, 0, 1); PG8_STAGE(PG8_SB(0, 0), b2, voffB);
            PG8_BAR; PG8_WAIT_L(0); PG8_MMA(0, 1, At, B1); PG8_BAR;
            PG8_LDA(At, 0, 1); PG8_STAGE(PG8_SA(0, 0), a2, voffA);
            PG8_BAR; PG8_WAIT_L(0); PG8_MMA(1, 0, At, B0); PG8_BAR; PG8_SCHED;
            PG8_STAGE(PG8_SB(0, 1), b2 + hstepB, voffB);
            PG8_WAIT_V(6); PG8_BAR; PG8_MMA(1, 1, At, B1); PG8_BAR;
            PG8_LDB(B0, 1, 0); PG8_SCHED; PG8_LDA(At, 1, 0); PG8_STAGE(PG8_SA(0, 1), a2 + hstepA, voffA);
            PG8_WAIT_L(8); PG8_BAR; PG8_WAIT_L(0); PG8_MMA(0, 0, At, B0); PG8_BAR; PG8_SCHED;
            PG8_LDB(B1, 1, 1); PG8_STAGE(PG8_SB(1, 0), b3, voffB);
            PG8_BAR; PG8_WAIT_L(0); PG8_MMA(0, 1, At, B1); PG8_BAR;
            PG8_LDA(At, 1, 1); PG8_STAGE(PG8_SA(1, 0), a3, voffA);
            PG8_BAR; PG8_WAIT_L(0); PG8_MMA(1, 0, At, B0); PG8_BAR; PG8_SCHED;
            PG8_STAGE(PG8_SB(1, 1), b3 + hstepB, voffB);
            PG8_WAIT_V(6); PG8_BAR; PG8_MMA(1, 1, At, B1); PG8_BAR;
            }
        }
        if constexpr (ALIGN_EPI) { if (wr == 0) PG8_BAR; }
        bool keep = false; if constexpr (!Epi::AFTER_DRAIN) { keep = E(acc, cur, wr, wc, fr, fq); S.done(cur); }
        if (!has_next) break;
        if (!keep)
#pragma unroll
        for (int a = 0; a < 2; ++a)
#pragma unroll
            for (int b = 0; b < 2; ++b)
#pragma unroll
                for (int m = 0; m < 4; ++m)
#pragma unroll
                    for (int n = 0; n < 2; ++n) acc[a][b][m][n] = (f32x4){0.f, 0.f, 0.f, 0.f};
        cur = nxt; cA = nA; cB = nB; ++ui;
        if constexpr (ALIGN_EPI) { if (wr == 1) PG8_BAR; }
    }
    PG8_WAIT_V(0);
    if constexpr (!ALIGN_EPI) { if (wr == 0) PG8_BAR; }
    PG8_BAR;
    if constexpr (Epi::AFTER_DRAIN) { E.fused(acc, cur, wr, wc, fr, fq, lds, wid, lane); S.done(cur); }
#undef PG8_SA
#undef PG8_SB
#undef PG8_STAGE
#undef PG8_LDA
#undef PG8_LDB
#undef PG8_MMA
#undef PG8_WAIT_V
#undef PG8_WAIT_L
#undef PG8_BAR
#undef PG8_SCHED
}
}

#ifndef PG8_SP2
#define PG8_SP2 true
#endif
#ifndef PG8_ALIGN
#define PG8_ALIGN true
#endif

#include <hip/hip_bf16.h>
#include <cmath>
namespace attn_body {
using bf16=__hip_bfloat16;
using bf16x8=__attribute__((ext_vector_type(8)))short;
using s16x4=__attribute__((ext_vector_type(4)))short;
using f32x16=__attribute__((ext_vector_type(16)))float;
using u32x4=__attribute__((ext_vector_type(4)))unsigned;
using f32x4v=__attribute__((ext_vector_type(4)))float;
constexpr int SEQ=4096,D=64;
constexpr int NW=8,QBLK=32,QB=QBLK*NW,KVBLK=64,NQB=SEQ/QB;
constexpr int ATTN_UNIT_ROWS=QB;
__device__ __forceinline__ int crow(int r,int hi){return (r&3)+8*(r>>2)+4*hi;}
#define SBAR() __builtin_amdgcn_sched_barrier(0)
__device__ __forceinline__ void cmask(f32x16&p0,f32x16&p1,int jb,int qrel,int hi){
  const float NEG=-INFINITY; int kb=64*jb+4*hi;
  #pragma unroll
  for(int r=0;r<16;++r){int kv=kb+(r&3)+8*(r>>2); if(kv>qrel)p0[r]=NEG; if(kv+32>qrel)p1[r]=NEG;}
}

constexpr int NSLOT=3, SLOTB=8192;
constexpr int LDS_K=0, LDS_V=NSLOT*SLOTB, LDS_WS=2*NSLOT*SLOTB, LDS_OST=LDS_WS+NW*64*4, LDS_BIAS=LDS_OST+NW*4096, LDS_BYTES=LDS_BIAS+SEQ*4;
constexpr float C2=0.125f*1.4426950408889634f;
__device__ __forceinline__ void glds16(const void*gsrc,unsigned lds_dst){unsigned keep;
  asm volatile("s_mov_b32 %0, m0\n\ts_mov_b32 m0, %2\n\ts_nop 0\n\tglobal_load_lds_dwordx4 %1, off\n\ts_mov_b32 m0, %0":"=&s"(keep):"v"(gsrc),"s"(lds_dst):"memory");}
__device__ __forceinline__ float max3f(float a,float b,float c){float r;asm("v_max3_f32 %0, %1, %2, %3":"=v"(r):"v"(a),"v"(b),"v"(c));return r;}
__device__ __forceinline__ float max2f(float a,float b){float r;asm("v_max_f32_e32 %0, %1, %2":"=v"(r):"v"(a),"v"(b));return r;}
__device__ __forceinline__ float fadd_s(float a,float b){float r;asm("v_add_f32_e32 %0, %1, %2":"=v"(r):"v"(a),"v"(b));return r;}
__device__ __forceinline__ float fsub_s(float a,float b){float r;asm("v_sub_f32_e32 %0, %1, %2":"=v"(r):"v"(a),"v"(b));return r;}
typedef float f32x2_t __attribute__((ext_vector_type(2))); typedef __bf16 bf16x2_t __attribute__((ext_vector_type(2)));
__device__ __forceinline__ unsigned cvtpk_s(float lo,float hi){f32x2_t v={lo,hi};bf16x2_t b=__builtin_convertvector(v,bf16x2_t);return __builtin_bit_cast(unsigned,b);}
#define WAIT_BAR(N) asm volatile("s_waitcnt vmcnt(" #N ") lgkmcnt(0)\n\ts_barrier":::"memory")

__device__ __forceinline__ void qkt(f32x16&p0,f32x16&p1,const char*Kslot,const bf16x8*qr,int r32,int hi){
  const char*kb=Kslot+hi*1024+r32*16;
  #pragma unroll
  for(int d0=0;d0<4;++d0){
    const bf16x8 b0=*reinterpret_cast<const bf16x8*>(kb+d0*2048);
    const bf16x8 b1=*reinterpret_cast<const bf16x8*>(kb+d0*2048+512);
    {p0=__builtin_amdgcn_mfma_f32_32x32x16_bf16(b0,qr[d0],p0,0,0,0);p1=__builtin_amdgcn_mfma_f32_32x32x16_bf16(b1,qr[d0],p1,0,0,0);}}
}
typedef __attribute__((address_space(3))) const char* lds_cptr;
typedef short v4i16_t __attribute__((ext_vector_type(4)));
__device__ __forceinline__ void kload8(bf16x8*kf,lds_cptr kp){
  kf[0]=*(const __attribute__((address_space(3))) bf16x8*)(kp);      kf[1]=*(const __attribute__((address_space(3))) bf16x8*)(kp+512);
  kf[2]=*(const __attribute__((address_space(3))) bf16x8*)(kp+2048); kf[3]=*(const __attribute__((address_space(3))) bf16x8*)(kp+2560);
  kf[4]=*(const __attribute__((address_space(3))) bf16x8*)(kp+4096); kf[5]=*(const __attribute__((address_space(3))) bf16x8*)(kp+4608);
  kf[6]=*(const __attribute__((address_space(3))) bf16x8*)(kp+6144); kf[7]=*(const __attribute__((address_space(3))) bf16x8*)(kp+6656);
}
__device__ __forceinline__ void kload2(bf16x8*kf,lds_cptr kp,int j){ kf[2*j]=*(const __attribute__((address_space(3))) bf16x8*)(kp+j*2048); kf[2*j+1]=*(const __attribute__((address_space(3))) bf16x8*)(kp+j*2048+512); }
__device__ __forceinline__ s16x4 vtr(lds_cptr p){ return __builtin_bit_cast(s16x4,__builtin_amdgcn_ds_read_tr16_b64_v4i16((__attribute__((address_space(3))) v4i16_t*)p)); }
__device__ __forceinline__ float rowmax(const f32x16&p0,const f32x16&p1){
  float a=max3f(p0[0],p0[1],p1[0]),b=max3f(p0[2],p0[3],p1[1]);a=max3f(a,p1[2],p1[3]);
  #pragma unroll
  for(int r=4;r<16;r+=4){a=max3f(a,p0[r],p0[r+1]);b=max3f(b,p0[r+2],p0[r+3]);a=max3f(a,p1[r],p1[r+1]);b=max3f(b,p1[r+2],p1[r+3]);}
  const float m=max2f(a,b);
  auto rr=__builtin_amdgcn_permlane32_swap(__float_as_uint(m),__float_as_uint(m),false,false);
  return max2f(__uint_as_float(rr[0]),__uint_as_float(rr[1]));
}
__device__ __forceinline__ void pv(f32x16*o,int vb,bf16x8 pa0,bf16x8 pa1,bf16x8 pa2,bf16x8 pa3){
  #pragma unroll
  for(int d0=0;d0<2;++d0){s16x4 lo[4],hi[4];
    #pragma unroll
    for(int ks=0;ks<4;++ks){
      asm volatile("ds_read_b64_tr_b16 %0,%1 offset:%c2":"=&v"(lo[ks]):"v"(vb),"i"(d0*4096+ks*1024):"memory");
      asm volatile("ds_read_b64_tr_b16 %0,%1 offset:%c2":"=&v"(hi[ks]):"v"(vb),"i"(d0*4096+ks*1024+512):"memory");}
    asm volatile("s_waitcnt lgkmcnt(0)":::"memory");SBAR();
    #define PK(k) (bf16x8){lo[k][0],lo[k][1],lo[k][2],lo[k][3],hi[k][0],hi[k][1],hi[k][2],hi[k][3]}
    o[d0]=__builtin_amdgcn_mfma_f32_32x32x16_bf16(pa0,PK(0),o[d0],0,0,0);
    o[d0]=__builtin_amdgcn_mfma_f32_32x32x16_bf16(pa1,PK(1),o[d0],0,0,0);
    o[d0]=__builtin_amdgcn_mfma_f32_32x32x16_bf16(pa2,PK(2),o[d0],0,0,0);
    o[d0]=__builtin_amdgcn_mfma_f32_32x32x16_bf16(pa3,PK(3),o[d0],0,0,0);
    #undef PK
  }
}

#ifndef ATTN_STORE16
#define ATTN_STORE16(p,v) (*(u32x4*)(p)=(v))
#endif
template<int THRL,bool HB,bool VW2> __device__ __forceinline__ void attn_unit(int qb,const bf16*Qp,const bf16*Kh,const bf16*Vh,bf16*Op,int ldq,int ldo,const float*biasg,const bf16*Gp,char*shm){
  int tid_=threadIdx.x; asm volatile("":"+v"(tid_)); const int tid=tid_,lane=tid&63,r32=lane&31,hi=lane>>5; const int wid=__builtin_amdgcn_readfirstlane(tid>>6);
  const int q0=qb*QB;
  constexpr int VS=VW2?2:1, L_WS=LDS_V+NSLOT*SLOTB*VS, L_OST=L_WS+NW*64*4, L_BIAS=L_OST+NW*4096;
  static_assert(!(HB&&VW2)&&L_BIAS+(HB?SEQ*4:0)<=131072,"attention LDS map");
  const bf16*Qw=Qp+(long)(q0+wid*QBLK)*ldq;
  const unsigned lds0=(unsigned)(uintptr_t)shm;
  float*wsf=(float*)(shm+L_WS)+wid*64;
  const bf16*ksrc=Kh+(long)lane*ldq+wid*8;
  const bf16*vsrc=Vh+(long)(16*(wid&3)+(lane>>2))*ldq+(wid>>2)*32+(lane&3)*8;
  const unsigned kdst=lds0+LDS_K+wid*1024, vdst=lds0+LDS_V+wid*1024;
  #define DMA_K(t,slot) glds16(ksrc+(long)(NT-1-(t))*KVBLK*ldq,(unsigned)__builtin_amdgcn_readfirstlane(kdst+(slot)))
  #define DMA_V(t,slot) do{ glds16(vsrc+(long)(NT-1-(t))*KVBLK*ldq,(unsigned)__builtin_amdgcn_readfirstlane(vdst+(slot)*VS)); \
    if(VW2) glds16(vsrc+(long)(NT-1-(t))*KVBLK*ldq+64,(unsigned)__builtin_amdgcn_readfirstlane(vdst+(slot)*VS+8192)); }while(0)
  const int vb0=(int)(lds0+LDS_V)+((lane>>4)&1)*32+(lane&3)*8+(4*hi+((lane&15)>>2))*64;
  const char*Kbase=shm+LDS_K; bf16x8 kf[8];
  const lds_cptr shm3=(lds_cptr)shm; const lds_cptr kp0=shm3+LDS_K+hi*1024+r32*16; const lds_cptr vp0=shm3+LDS_V+((lane>>4)&1)*32+(lane&3)*8+(4*hi+((lane&15)>>2))*64;
  const int NT=(q0+QB)/KVBLK;
  if(HB){ float*bl=(float*)(shm+L_BIAS); for(int i=tid;i<q0+QB;i+=NW*64) bl[i]=biasg[i]; }
  DMA_K(0,0);DMA_V(0,0);DMA_K(1,SLOTB);
  bf16x8 qr[4];
  #pragma unroll
  for(int d0=0;d0<4;++d0)qr[d0]=*reinterpret_cast<const bf16x8*>(&Qw[(long)r32*ldq+d0*16+hi*8]);
  float mhat=0.f,l_reg=0.f;f32x16 o[4];o[0]=f32x16{};o[1]=f32x16{};o[2]=f32x16{};o[3]=f32x16{};f32x16 negm=f32x16{};if(!HB&&!VW2)asm volatile("":"+v"(negm));
  const int qrel=wid*QBLK+r32;
  const lds_cptr bias3=shm3+L_BIAS+hi*16;
  #define BLD(P0,P1,tt) do{ const lds_cptr bp_=bias3+(NT-1-(tt))*256; \
    _Pragma("unroll") for(int g_=0;g_<4;++g_){ const f32x4v x_=*(const __attribute__((address_space(3))) f32x4v*)(bp_+32*g_); const f32x4v y_=*(const __attribute__((address_space(3))) f32x4v*)(bp_+128+32*g_); \
      P0[4*g_]=x_[0];P0[4*g_+1]=x_[1];P0[4*g_+2]=x_[2];P0[4*g_+3]=x_[3]; P1[4*g_]=y_[0];P1[4*g_+1]=y_[1];P1[4*g_+2]=y_[2];P1[4*g_+3]=y_[3]; } }while(0)
  #define BSUB(P0,P1) do{ _Pragma("unroll") for(int r=0;r<16;++r){P0[r]-=mhat;P1[r]-=mhat;} }while(0)
  #define CMASK(P0,P1,t) do{int jb_=3-(t); if(jb_>=0)cmask(P0,P1,jb_,qrel,hi);}while(0)
  bool resc=false;
  #define START(P0,P1) do{ const float rm=rowmax(P0,P1); resc=false; \
    if(__any(rm>(float)THRL)){ const float dl=__builtin_fmaxf(rm,0.f); mhat=fadd_s(mhat,dl); \
      _Pragma("unroll") for(int r=0;r<16;++r){P0[r]=fsub_s(P0[r],dl);P1[r]=fsub_s(P1[r],dl);} \
      if(!HB&&!VW2){ _Pragma("unroll") for(int r=0;r<16;++r)negm[r]=-mhat; asm volatile("":"+v"(negm)); } } \
    _Pragma("unroll") for(int r=0;r<16;++r)P0[r]=__builtin_amdgcn_exp2f(P0[r]); }while(0)
  #define RESC() do{ if(resc){ asm volatile("s_waitcnt lgkmcnt(0)":::"memory"); \
      _Pragma("unroll") for(int d_=0;d_<2*VS;++d_) _Pragma("unroll") for(int r=0;r<16;++r)o[d_][r]*=wsf[crow(r,hi)]; } }while(0)
  f32x16 pA0,pA1,pB0,pB1;
  int sl_prev=0,sl_cur=0,sl_next=SLOTB;
  #define ROT() do{sl_prev=sl_cur;sl_cur=sl_next;sl_next=(sl_next==(NSLOT-1)*SLOTB)?0:sl_next+SLOTB;}while(0)
  DMA_K(2,2*SLOTB);
  #define WB3() do{ if(VW2){WAIT_BAR(4);}else{WAIT_BAR(3);} }while(0)
  #define WB2() do{ if(VW2){WAIT_BAR(3);}else{WAIT_BAR(2);} }while(0)
  #define WB1() do{ if(VW2){WAIT_BAR(2);}else{WAIT_BAR(1);} }while(0)
  WB3();
  if(HB){BLD(pA0,pA1,0);}else if(VW2){pA0=f32x16{};pA1=f32x16{};}else{pA0=negm;pA1=negm;}
  qkt(pA0,pA1,Kbase,qr,r32,hi);asm volatile("s_nop 15\n\ts_nop 7":"+v"(pA0),"+v"(pA1));CMASK(pA0,pA1,0);
  START(pA0,pA1);
  if(HB){BLD(pB0,pB1,1); BSUB(pB0,pB1);}
  _Pragma("unroll") for(int r=0;r<16;++r)pA1[r]=__builtin_amdgcn_exp2f(pA1[r]);
  WAIT_BAR(0);
  DMA_K(3,0);DMA_V(1,SLOTB);
  ROT();
  kload8(kf,kp0+sl_cur);
  WB2();
  s16x4 vlo[8],vhi[8]; u32x4 pw0,pw1,pw2,pw3;
  #define PKW(P,B) cvtpk_s(P[B],P[B+1])
  #define PAF(k) __builtin_bit_cast(bf16x8,pw##k)
  #define VFR(i) (bf16x8){vlo[i][0],vlo[i][1],vlo[i][2],vlo[i][3],vhi[i][0],vhi[i][1],vhi[i][2],vhi[i][3]}
  #define PIN(x) asm volatile("":"+v"(x))
  #define MX3(a,b,c) __builtin_fmaxf(__builtin_fmaxf((a),(b)),(c))
  #define GAPA(MF,A0,A1,A2,A3,W0,W1,PW) do{ MF; sacc+=A0; sacc+=A1; sacc+=A2; sacc+=A3; PIN(sacc); W0; W1; PIN(PW); SBAR(); }while(0)
  #define EX(v) __builtin_amdgcn_exp2f(v)
  #define GAPB(MF,X,B) do{ MF; X[B]=EX(X[B]); X[B+1]=EX(X[B+1]); X[B+2]=EX(X[B+2]); X[B+3]=EX(X[B+3]); PIN(X); SBAR(); }while(0)
  #define GAPB2(MF,X,B) do{ MF; X[B]=EX(X[B]); X[B+1]=EX(X[B+1]); PIN(X); SBAR(); }while(0)
  #define VRD(i) do{ vlo[i]=vtr(vp_+(((i)>>2)*4096+((i)&3)*1024)); vhi[i]=vtr(vp_+(((i)>>2)*4096+((i)&3)*1024+512)); }while(0)
  #define VRDH(i) do{ vlo[i]=vtr(vp_+8192+(((i)>>2)*4096+((i)&3)*1024)); vhi[i]=vtr(vp_+8192+(((i)>>2)*4096+((i)&3)*1024+512)); }while(0)
  #define KRD(G,j) do{ if(G){ kload2(kf,kp0+sl_next,j); SBAR(); } }while(0)
  #define STEP(C0,C1,P0,P1,t,GK,GV,GL) do{ SBAR(); \
    const lds_cptr vp_=vp0+sl_prev*VS; \
    if(VW2){ const float nm_=-mhat; _Pragma("unroll") for(int r=0;r<16;++r){C0[r]=nm_;C1[r]=nm_;} } \
    VRD(0); SBAR(); float sacc=(P0[0]+P0[1]); \
    GAPA(C0=__builtin_amdgcn_mfma_f32_32x32x16_bf16(kf[0],qr[0],(HB||VW2)?C0:negm,0,0,0), P0[2],P0[3],P0[4],P0[5],     pw0[0]=PKW(P0,0), pw0[1]=PKW(P0,2), pw0); \
    VRD(4); SBAR(); GAPA(C1=__builtin_amdgcn_mfma_f32_32x32x16_bf16(kf[1],qr[0],(HB||VW2)?C1:negm,0,0,0), P0[6],P0[7],P0[8],P0[9],     pw0[2]=PKW(P0,4), pw0[3]=PKW(P0,6), pw0); \
    VRD(1); SBAR(); GAPA(C0=__builtin_amdgcn_mfma_f32_32x32x16_bf16(kf[2],qr[1],C0,0,0,0),   P0[10],P0[11],P0[12],P0[13], pw1[0]=PKW(P0,8), pw1[1]=PKW(P0,10), pw1); \
    VRD(5); SBAR(); GAPA(C1=__builtin_amdgcn_mfma_f32_32x32x16_bf16(kf[3],qr[1],C1,0,0,0),   P0[14],P0[15],P1[0],P1[1],   pw1[2]=PKW(P0,12),pw1[3]=PKW(P0,14), pw1); \
    VRD(2); SBAR(); GAPA(C0=__builtin_amdgcn_mfma_f32_32x32x16_bf16(kf[4],qr[2],C0,0,0,0),   P1[2],P1[3],P1[4],P1[5],     pw2[0]=PKW(P1,0), pw2[1]=PKW(P1,2), pw2); \
    VRD(6); SBAR(); GAPA(C1=__builtin_amdgcn_mfma_f32_32x32x16_bf16(kf[5],qr[2],C1,0,0,0),   P1[6],P1[7],P1[8],P1[9],     pw2[2]=PKW(P1,4), pw2[3]=PKW(P1,6), pw2); \
    VRD(3); SBAR(); GAPA(C0=__builtin_amdgcn_mfma_f32_32x32x16_bf16(kf[6],qr[3],C0,0,0,0),   P1[10],P1[11],P1[12],P1[13], pw3[0]=PKW(P1,8), pw3[1]=PKW(P1,10), pw3); \
    VRD(7); SBAR(); GAPA(C1=__builtin_amdgcn_mfma_f32_32x32x16_bf16(kf[7],qr[3],C1,0,0,0),   P1[14],P1[15],0.f,0.f,       pw3[2]=PKW(P1,12),pw3[3]=PKW(P1,14), pw3); \
    l_reg+=sacc; \
    if(GK){DMA_K((t)+3,sl_cur);} if(GV){DMA_V((t)+1,sl_next);} \
    CMASK(C0,C1,t); \
    { float a=MX3(C0[0],C0[1],C1[0]),b=MX3(C0[2],C0[3],C1[1]); a=MX3(a,C1[2],C1[3]); \
      _Pragma("unroll") for(int r=4;r<16;r+=4){a=MX3(a,C0[r],C0[r+1]);b=MX3(b,C0[r+2],C0[r+3]);a=MX3(a,C1[r],C1[r+1]);b=MX3(b,C1[r+2],C1[r+3]);} \
      float rm=__builtin_fmaxf(a,b); { auto rr=__builtin_amdgcn_permlane32_swap(__float_as_uint(rm),__float_as_uint(rm),false,false); rm=__builtin_fmaxf(__uint_as_float(rr[0]),__uint_as_float(rr[1])); } \
      resc=false; \
      if(__builtin_expect(__any(rm>(float)THRL),0)){ const float dl=__builtin_fmaxf(rm,0.f); mhat+=dl; \
        _Pragma("unroll") for(int r=0;r<16;++r){C0[r]-=dl;C1[r]-=dl;} \
        if(!HB&&!VW2){ _Pragma("unroll") for(int r=0;r<16;++r)negm[r]=-mhat; asm volatile("":"+v"(negm)); } \
        const float f=__builtin_amdgcn_exp2f(-dl); l_reg*=f; if(hi==0)wsf[r32]=f; resc=true; } } \
    SBAR(); \
    if(HB&&(GL)){ BLD(P0,P1,(t)+1); SBAR(); } \
    if(!VW2){ \
    GAPB(o[0]=__builtin_amdgcn_mfma_f32_32x32x16_bf16(PAF(0),VFR(0),o[0],0,0,0), C0,0); \
    GAPB(o[1]=__builtin_amdgcn_mfma_f32_32x32x16_bf16(PAF(0),VFR(4),o[1],0,0,0), C0,4); \
    KRD(GL,0); GAPB(o[0]=__builtin_amdgcn_mfma_f32_32x32x16_bf16(PAF(1),VFR(1),o[0],0,0,0), C0,8); \
    KRD(GL,1); GAPB(o[1]=__builtin_amdgcn_mfma_f32_32x32x16_bf16(PAF(1),VFR(5),o[1],0,0,0), C0,12); \
    KRD(GL,2); GAPB(o[0]=__builtin_amdgcn_mfma_f32_32x32x16_bf16(PAF(2),VFR(2),o[0],0,0,0), C1,0); \
    KRD(GL,3); GAPB(o[1]=__builtin_amdgcn_mfma_f32_32x32x16_bf16(PAF(2),VFR(6),o[1],0,0,0), C1,4); \
    GAPB(o[0]=__builtin_amdgcn_mfma_f32_32x32x16_bf16(PAF(3),VFR(3),o[0],0,0,0), C1,8); \
    GAPB(o[1]=__builtin_amdgcn_mfma_f32_32x32x16_bf16(PAF(3),VFR(7),o[1],0,0,0), C1,12); \
    } else {   \
    GAPB2(o[0]=__builtin_amdgcn_mfma_f32_32x32x16_bf16(PAF(0),VFR(0),o[0],0,0,0), C0,0); VRDH(0); SBAR(); \
    GAPB2(o[1]=__builtin_amdgcn_mfma_f32_32x32x16_bf16(PAF(0),VFR(4),o[1],0,0,0), C0,2); VRDH(4); SBAR(); \
    KRD(GL,0); GAPB2(o[0]=__builtin_amdgcn_mfma_f32_32x32x16_bf16(PAF(1),VFR(1),o[0],0,0,0), C0,4); VRDH(1); SBAR(); \
    KRD(GL,1); GAPB2(o[1]=__builtin_amdgcn_mfma_f32_32x32x16_bf16(PAF(1),VFR(5),o[1],0,0,0), C0,6); VRDH(5); SBAR(); \
    KRD(GL,2); GAPB2(o[0]=__builtin_amdgcn_mfma_f32_32x32x16_bf16(PAF(2),VFR(2),o[0],0,0,0), C0,8); VRDH(2); SBAR(); \
    KRD(GL,3); GAPB2(o[1]=__builtin_amdgcn_mfma_f32_32x32x16_bf16(PAF(2),VFR(6),o[1],0,0,0), C0,10); VRDH(6); SBAR(); \
    GAPB2(o[0]=__builtin_amdgcn_mfma_f32_32x32x16_bf16(PAF(3),VFR(3),o[0],0,0,0), C0,12); VRDH(3); SBAR(); \
    GAPB2(o[1]=__builtin_amdgcn_mfma_f32_32x32x16_bf16(PAF(3),VFR(7),o[1],0,0,0), C0,14); VRDH(7); SBAR(); \
    GAPB2(o[2]=__builtin_amdgcn_mfma_f32_32x32x16_bf16(PAF(0),VFR(0),o[2],0,0,0), C1,0); \
    GAPB2(o[3]=__builtin_amdgcn_mfma_f32_32x32x16_bf16(PAF(0),VFR(4),o[3],0,0,0), C1,2); \
    GAPB2(o[2]=__builtin_amdgcn_mfma_f32_32x32x16_bf16(PAF(1),VFR(1),o[2],0,0,0), C1,4); \
    GAPB2(o[3]=__builtin_amdgcn_mfma_f32_32x32x16_bf16(PAF(1),VFR(5),o[3],0,0,0), C1,6); \
    GAPB2(o[2]=__builtin_amdgcn_mfma_f32_32x32x16_bf16(PAF(2),VFR(2),o[2],0,0,0), C1,8); \
    GAPB2(o[3]=__builtin_amdgcn_mfma_f32_32x32x16_bf16(PAF(2),VFR(6),o[3],0,0,0), C1,10); \
    GAPB2(o[2]=__builtin_amdgcn_mfma_f32_32x32x16_bf16(PAF(3),VFR(3),o[2],0,0,0), C1,12); \
    GAPB2(o[3]=__builtin_amdgcn_mfma_f32_32x32x16_bf16(PAF(3),VFR(7),o[3],0,0,0), C1,14); \
    } \
    if(HB&&(GL)){ BSUB(P0,P1); } \
    }while(0)
  int t=1;
  #undef CMASK
  #define CMASK(P0,P1,t) do{int jb_=3-(t); if(jb_>=0)cmask(P0,P1,jb_,qrel,hi);}while(0)
  for(;t+5<NT;t+=2){
    STEP(pB0,pB1,pA0,pA1,t,true,true,true);     WB2(); RESC(); ROT();
    STEP(pA0,pA1,pB0,pB1,t+1,true,true,true);   WB2(); RESC(); ROT();
  }
  #undef CMASK
  #define CMASK(P0,P1,t) do{int jb_=3-(t); if(jb_>=0)cmask(P0,P1,jb_,qrel,hi);}while(0)
  #define ENDW(tt) do{ if((tt)+3<NT){WB2();} else if((tt)+2<NT){WB1();} else {WAIT_BAR(0);} }while(0)
  for(;t+1<NT;t+=2){
    STEP(pB0,pB1,pA0,pA1,t,(t+3<NT),(t+1<NT),(t+1<NT));       ENDW(t);   RESC(); ROT();
    STEP(pA0,pA1,pB0,pB1,t+1,(t+4<NT),(t+2<NT),(t+2<NT));     ENDW(t+1); RESC(); ROT();
  }
  STEP(pB0,pB1,pA0,pA1,NT-1,false,false,false); RESC();
  { float sacc=pB0[0]+pB0[1]; _Pragma("unroll") for(int r=2;r<16;++r)sacc+=pB0[r]; _Pragma("unroll") for(int r=0;r<16;++r)sacc+=pB1[r]; l_reg+=sacc;
    pw0=(u32x4){PKW(pB0,0),PKW(pB0,2),PKW(pB0,4),PKW(pB0,6)};pw1=(u32x4){PKW(pB0,8),PKW(pB0,10),PKW(pB0,12),PKW(pB0,14)};pw2=(u32x4){PKW(pB1,0),PKW(pB1,2),PKW(pB1,4),PKW(pB1,6)};pw3=(u32x4){PKW(pB1,8),PKW(pB1,10),PKW(pB1,12),PKW(pB1,14)};
    SBAR(); pv(o,vb0+sl_cur*VS,PAF(0),PAF(1),PAF(2),PAF(3)); if(VW2){ SBAR(); pv(o+2,vb0+sl_cur*VS+8192,PAF(0),PAF(1),PAF(2),PAF(3)); } }
  #undef PKW
  #undef PAF
  #undef VFR
  #undef PIN
  #undef MX3
  #undef GAPA
  #undef GAPB
  #undef GAPB2
  #undef EX
  #undef VRD
  #undef VRDH
  #undef KRD
  #undef STEP
  #undef ENDW
  {auto rr=__builtin_amdgcn_permlane32_swap(__float_as_uint(l_reg),__float_as_uint(l_reg),false,false);l_reg=__uint_as_float(rr[0])+__uint_as_float(rr[1]);}
  if(hi==0)wsf[32+r32]=l_reg;asm volatile("s_waitcnt lgkmcnt(0)":::"memory");
  u32x4 gt[4];
  if(HB){ const bf16*Gw=Gp+(long)(q0+wid*QBLK)*ldq;
    #pragma unroll
    for(int i=0;i<4;++i)gt[i]=*(const u32x4*)(Gw+(long)(i*8+(lane>>3))*ldq+(lane&7)*8); }
  float rli[16];
  #pragma unroll
  for(int r=0;r<16;++r)rli[r]=__builtin_amdgcn_rcpf(wsf[32+crow(r,hi)]);
  bf16*Ow=Op+(long)(q0+wid*QBLK)*ldo;
  { bf16*stg=(bf16*)(shm+L_OST)+wid*2048;
    #pragma unroll
    for(int hv=0;hv<VS;++hv){
    #pragma unroll
    for(int r=0;r<16;++r){const int orow=crow(r,hi);
      #pragma unroll
      for(int d0=0;d0<2;++d0)stg[orow*64+d0*32+r32]=__float2bfloat16(o[2*hv+d0][r]*rli[r]);}
    asm volatile("s_waitcnt lgkmcnt(0)":::"memory");
    #pragma unroll
    for(int i=0;i<4;++i){const int row=i*8+(lane>>3),ch=lane&7; u32x4 v=*(const u32x4*)(stg+row*64+ch*8);
      if(HB){ _Pragma("unroll") for(int e=0;e<4;++e){ const float ol=__uint_as_float(v[e]<<16),oh=__uint_as_float(v[e]&0xffff0000u),gl=__uint_as_float(gt[i][e]<<16),gh=__uint_as_float(gt[i][e]&0xffff0000u);
          const float sl=gl*__builtin_amdgcn_rcpf(1.f+__builtin_amdgcn_exp2f(fminf(-gl*1.4426950408889634f,100.f))),sh=gh*__builtin_amdgcn_rcpf(1.f+__builtin_amdgcn_exp2f(fminf(-gh*1.4426950408889634f,100.f)));
          v[e]=cvtpk_s(ol*sl,oh*sh); } }
      ATTN_STORE16(Ow+(long)row*ldo+hv*64+ch*8,v);}
    asm volatile("s_waitcnt lgkmcnt(0)":::"memory"); } }
  asm volatile("s_waitcnt lgkmcnt(0)\n\ts_barrier":::"memory");
  #undef BLD
  #undef BSUB
  #undef DMA_K
  #undef DMA_V
  #undef CMASK
  #undef START
  #undef RESC
  #undef ROT
  #undef WB3
  #undef WB2
  #undef WB1
}
constexpr int ATTN_LDS_BYTES=LDS_BYTES;
#undef SBAR
#undef WAIT_BAR
}


#include <hip/hip_cooperative_groups.h>
namespace cg = cooperative_groups;
#define LAS __attribute__((address_space(3)))
typedef unsigned short bf16r;
typedef unsigned v4u __attribute__((ext_vector_type(4)));
typedef float f32x4 __attribute__((ext_vector_type(4)));

constexpr int NWAVES = 8, NTHR = 512;
constexpr int NB = 4, SEQ = 4096, DM = 1024, T = NB * SEQ, DEPTH = 2, INW = 9224, PW = pg8::PW, NMG = 3072;
constexpr float RMS_EPS = 1e-6f;
constexpr size_t MiB = 1u << 20;
constexpr size_t WS_CTL = 0, CTL_BYTES = 65536;
constexpr size_t WS_LOGF = 2 * MiB;
constexpr size_t WS_CNEG = 2 * MiB + 512 * 1024;
constexpr size_t WS_CS = 3 * MiB;
constexpr size_t WS_W1 = 4 * MiB;
constexpr size_t WS_WMG = 16 * MiB;
constexpr size_t WS_WBR = 22 * MiB;
constexpr size_t WS_WO = 25 * MiB;
constexpr size_t WS_H = 28 * MiB;
constexpr size_t WS_OD = 60 * MiB;
constexpr size_t WS_P = 92 * MiB;
constexpr size_t WS_END = 284 * MiB;
constexpr int LDS_BYTES = 131072 + 256, LDS_MISC = 131072;
#ifndef PHM
#define PHM 127
#endif
#ifndef WGM_B
#define WGM_B 2
#endif
#ifndef WGM_G
#define WGM_G 2
#endif
#ifndef REP_A
#define REP_A 1
#endif
#ifndef REP_B
#define REP_B 1
#endif
#ifndef REP_W
#define REP_W 1
#endif
#ifndef REP_X
#define REP_X 1
#endif
#ifndef REP_Y
#define REP_Y 1
#endif
#ifndef REP_C
#define REP_C 1
#endif
#ifndef REP_G
#define REP_G 1
#endif
#ifndef REP_D
#define REP_D 1
#endif
#ifndef REP_E
#define REP_E 1
#endif
#ifndef REP_S
#define REP_S 0
#endif

__device__ __forceinline__ unsigned pk2(float lo, float hi) { return pg8::cvt_pk_bf16(lo, hi); }
__device__ __forceinline__ float wave_sum(float v) {
#pragma unroll
    for (int o = 1; o < 64; o <<= 1) v += __shfl_xor(v, o);
    return v;
}
__device__ __forceinline__ float silu_f(float v) { return v * __builtin_amdgcn_rcpf(1.f + __builtin_amdgcn_exp2f(fminf(-v * 1.4426950408889634f, 100.f))); }

template <int MODE> __device__ __forceinline__ int cmap(int n) {
    if (MODE == 1) {
        int o = n + (n >= 1536 ? 8 : 0);
        if (n >= 2048 && n < 3072) { const int w = n & 63; if (w < 16) o = (n & ~63) + 8 + ((w & 1) ? 8 + (w >> 1) : (w >> 1)); }
        return o;
    }
    if (MODE == 2) return 6152 + n;
    return n;
}
template <int MODE> __device__ __forceinline__ void transpose_item(const float* W, int ldw, int K, int N, bf16r* WT, LAS float* scr, int item, int lane) {
    const int nblk = N / 32, kb = item / nblk, nb = item % nblk, k0 = 64 * kb, n0 = 32 * nb;
    const int oc = cmap<MODE>(n0 + (lane & 31));
#pragma unroll
    for (int i = 0; i < 32; ++i) { const int kk = 2 * i + (lane >> 5); scr[kk * 33 + (lane & 31)] = W[(size_t)(k0 + kk) * ldw + oc]; }
    asm volatile("s_waitcnt lgkmcnt(0)" ::: "memory");
    const int c = lane & 7;
#pragma unroll
    for (int j = 0; j < 4; ++j) { const int n = (lane >> 3) + 8 * j; const LAS float* s = scr + (8 * c) * 33 + n;
        v4u o; o.x = pk2(s[0 * 33], s[1 * 33]); o.y = pk2(s[2 * 33], s[3 * 33]); o.z = pk2(s[4 * 33], s[5 * 33]); o.w = pk2(s[6 * 33], s[7 * 33]);
        *(v4u*)(WT + (size_t)(n0 + n) * K + k0 + 8 * c) = o; }
    asm volatile("s_waitcnt lgkmcnt(0)" ::: "memory");
}

#define XB_TMO      128
#define XB_XCNT(j)  (256  + 64 * (j))
#define XB_XSUB(j)  (1280 + 64 * (j))
#define XB_XGEN(j)  (2304 + 64 * (j))
#define XB_TOP      3328
#define XB_TOPGEN   3392
#define XCD_BAR_WORDS 3456
#define XB_SPIN_CAP (1u << 18)

__device__ __forceinline__ unsigned xb_ld(unsigned* p)              { return __hip_atomic_load(p, __ATOMIC_RELAXED, __HIP_MEMORY_SCOPE_AGENT); }
__device__ __forceinline__ unsigned xb_add(unsigned* p, unsigned v) { return __hip_atomic_fetch_add(p, v, __ATOMIC_RELAXED, __HIP_MEMORY_SCOPE_AGENT); }
__device__ __forceinline__ unsigned xb_xcc_id() { return (unsigned)__builtin_amdgcn_s_getreg((3 << 11) | 20) & 0xFu; }
#define XB_SPIN(cond, bar) do { unsigned _sp = 0; while (cond) { __builtin_amdgcn_s_sleep(1); \
    if ((++_sp & 255u) == 0u) { if (xb_ld(&(bar)[XB_TMO])) break; if (_sp > XB_SPIN_CAP) { atomicAdd(&(bar)[XB_TMO], 1u); break; } } } } while (0)

struct XcdBarrier {
    unsigned* bar; unsigned x;
    volatile LAS unsigned* st;
};

__device__ __forceinline__ XcdBarrier xcd_barrier_post(unsigned* bar, volatile LAS unsigned* st) {
    XcdBarrier b; b.bar = bar; b.x = xb_xcc_id(); b.st = st;
    if (threadIdx.x == 0) (void)xb_add(&bar[XB_XCNT(b.x)], 1u);
    return b;
}
__device__ __forceinline__ void xcd_barrier_complete(unsigned* bar, unsigned x, unsigned& nloc, unsigned& nx) {
    const unsigned G = gridDim.x * gridDim.y * gridDim.z;
    unsigned sum, cnt, mine, sp = 0u;
    for (;;) {
        sum = 0u; cnt = 0u; mine = 0u;
#pragma unroll
        for (unsigned j = 0; j < 16; ++j) { const unsigned c = xb_ld(&bar[XB_XCNT(j)]); sum += c; cnt += (c > 0u) ? 1u : 0u; mine = (j == x) ? c : mine; }
        if (sum == G) break;
        __builtin_amdgcn_s_sleep(1);
        if ((++sp & 255u) == 0u) { if (xb_ld(&bar[XB_TMO])) break; if (sp > XB_SPIN_CAP) { atomicAdd(&bar[XB_TMO], 1u); break; } }
    }
    nloc = mine > 0u ? mine : 1u; nx = cnt > 0u ? cnt : 1u;
}

__device__ __forceinline__ void xcd_barrier(const XcdBarrier& b) {
    asm volatile("s_waitcnt vmcnt(0)" ::: "memory");
    __syncthreads();
    if (threadIdx.x == 0) {
        unsigned* bar = b.bar;
        __builtin_amdgcn_s_waitcnt(0);
        unsigned nloc = b.st[0], nx = b.st[1];
        if (nloc == 0u) { xcd_barrier_complete(bar, b.x, nloc, nx); b.st[0] = nloc; b.st[1] = nx; }
        const unsigned old = xb_add(&bar[XB_XSUB(b.x)], 1u);
        const unsigned gen = old / nloc;
        if (old + 1u == (gen + 1u) * nloc) {
            __builtin_amdgcn_fence(__ATOMIC_RELEASE, "agent");
            asm volatile("s_waitcnt vmcnt(0)" ::: "memory");
            const unsigned og = xb_add(&bar[XB_TOP], 1u);
            const unsigned tg = og / nx;
            if (og + 1u == (tg + 1u) * nx) xb_add(&bar[XB_TOPGEN], 1u);
            else XB_SPIN(xb_ld(&bar[XB_TOPGEN]) == tg, bar);
            __builtin_amdgcn_fence(__ATOMIC_ACQUIRE, "agent");
            xb_add(&bar[XB_XGEN(b.x)], 1u);
            asm volatile("s_waitcnt vmcnt(0)" ::: "memory");
        } else {
            XB_SPIN(xb_ld(&bar[XB_XGEN(b.x)]) == gen, bar);
            __builtin_amdgcn_fence(__ATOMIC_ACQUIRE, "agent");
            asm volatile("s_waitcnt vmcnt(0)" ::: "memory");
        }
    }
    __syncthreads();
}

struct Args { const void* in[17]; float* out; unsigned char* ws; };

__global__ void __launch_bounds__(NTHR, 2) fwd_megakernel(Args a) {
    extern __shared__ __attribute__((aligned(16))) unsigned char lds[];
    cg::grid_group grid = cg::this_grid();
    LAS unsigned char* ldsl = (LAS unsigned char*)lds;
    const int G = gridDim.x, bx = blockIdx.x;
    const int vcu = (G % 8 == 0) ? (bx % 8) * (G / 8) + bx / 8 : bx;
    const int NGW = G * NWAVES;
    unsigned char* ws = a.ws;
    const float* x_in = (const float*)a.in[0]; const int* positions = (const int*)a.in[1];
    float* LOGF = (float*)(ws + WS_LOGF); float* CNEG = (float*)(ws + WS_CNEG); float* CS = (float*)(ws + WS_CS);
    bf16r* W1t = (bf16r*)(ws + WS_W1); bf16r* Wmgt = (bf16r*)(ws + WS_WMG); bf16r* Wbrt = (bf16r*)(ws + WS_WBR); bf16r* Wot = (bf16r*)(ws + WS_WO);
    bf16r* H = (bf16r*)(ws + WS_H); bf16r* OD = (bf16r*)(ws + WS_OD); bf16r* P = (bf16r*)(ws + WS_P); bf16r* O16 = (bf16r*)(ws + WS_P);
    float* out = a.out;
    volatile LAS unsigned* misc = (volatile LAS unsigned*)(ldsl + LDS_MISC);
    if (threadIdx.x < 64) misc[threadIdx.x] = 0u;
    __syncthreads();
    XcdBarrier xbar = xcd_barrier_post((unsigned*)(ws + WS_CTL), misc);
    bool first_sync = true;
#define GSYNC() do { if (first_sync) { grid.sync(); first_sync = false; } else xcd_barrier(xbar); } while (0)
#ifdef PROBE_K
    unsigned long long ts_prev = __builtin_amdgcn_s_memrealtime(); float ts_acc = 0.f;
#define STAMP(k) do { const unsigned long long t_ = __builtin_amdgcn_s_memrealtime(); if ((k) == PROBE_K) ts_acc += (float)(t_ - ts_prev); \
        if ((k) == 5 && PROBE_K == 6) { GSYNC(); const unsigned long long t2_ = __builtin_amdgcn_s_memrealtime(); ts_acc += (float)(t2_ - t_); ts_prev = t2_; } else ts_prev = t_; } while (0)
#else
#define STAMP(k) do {} while (0)
#endif

#pragma unroll 1
    for (int l = 0; l <= DEPTH; ++l) {
        const bool fin = (l == DEPTH);
        for (int rep_ = 0; rep_ < (fin ? 1 : REP_A); ++rep_) {
        if (!fin && (PHM & 1)) {
            int tid = threadIdx.x; asm volatile("" : "+v"(tid)); const int lane = tid & 63, wave = __builtin_amdgcn_readfirstlane(tid >> 6), gw = bx * NWAVES + wave; (void)lane; (void)gw;
            LAS float* scr = (LAS float*)(ldsl + 32768 + wave * 8704);
            const float* win = (const float*)a.in[3] + (size_t)l * DM * INW;
            const float* wbf = (const float*)a.in[12] + (size_t)l * 512 * DM; const float* wbd = (const float*)a.in[13] + (size_t)l * 512 * DM;
            const float* wbc = (const float*)a.in[14] + (size_t)l * 512 * DM; const float* wo = (const float*)a.in[15] + (size_t)l * DM * DM;
            constexpr int I_1 = 16 * 192, I_G = 16 * 96, I_B = 8 * 32, I_O = 16 * 32, NITEMS = I_1 + I_G + 3 * I_B + I_O;
            for (int repw_ = 0; repw_ < REP_W; ++repw_)
            for (int it = gw; it < NITEMS; it += NGW) {
                int r = it;
                if (r < I_1) { transpose_item<1>(win, INW, DM, PW, W1t, scr, r, lane); continue; } r -= I_1;
                if (r < I_G) { transpose_item<2>(win, INW, DM, NMG, Wmgt, scr, r, lane); continue; } r -= I_G;
                if (r < I_B) { transpose_item<0>(wbf, DM, 512, DM, Wbrt, scr, r, lane); continue; } r -= I_B;
                if (r < I_B) { transpose_item<0>(wbd, DM, 512, DM, Wbrt + 512 * DM, scr, r, lane); continue; } r -= I_B;
                if (r < I_B) { transpose_item<0>(wbc, DM, 512, DM, Wbrt + 2 * 512 * DM, scr, r, lane); continue; } r -= I_B;
                transpose_item<0>(wo, DM, DM, DM, Wot, scr, r, lane);
            }
        }
        if (PHM & 2) {
            int tid = threadIdx.x; asm volatile("" : "+v"(tid)); const int lane = tid & 63, wave = __builtin_amdgcn_readfirstlane(tid >> 6), gw = bx * NWAVES + wave; (void)lane; (void)gw;
            LAS float* wff = (LAS float*)ldsl;
            if (!fin) { const float* win = (const float*)a.in[3] + (size_t)l * DM * INW;
                for (int i = tid; i < 8192; i += NTHR) { const int k = i >> 3, hh = i & 7; wff[hh * 1024 + k] = win[(size_t)k * INW + 1536 + hh]; } }
            __syncthreads();
            const float* xin = (l <= 1) ? x_in : out;
            const f32x4* postg = (const f32x4*)((const float*)a.in[16] + (size_t)(l > 0 ? l - 1 : 0) * DM);
            const f32x4* preg = (const f32x4*)((const float*)a.in[2] + (size_t)(fin ? 0 : l) * DM);
            const float* bfg = (const float*)a.in[4] + (fin ? 0 : l) * 8;
            for (int row0 = gw; row0 < T; row0 += 2 * NGW) {
                f32x4 v[2][4]; int rows[2]; bool ok[2];
#pragma unroll
                for (int q = 0; q < 2; ++q) { rows[q] = row0 + q * NGW; ok[q] = rows[q] < T; if (!ok[q]) rows[q] = row0;
                    const f32x4* xr = (const f32x4*)(xin + (size_t)rows[q] * DM) + lane;
#pragma unroll
                    for (int j = 0; j < 4; ++j) v[q][j] = xr[64 * j]; }
                if (l > 0) {
                    f32x4 ov[2][4]; float ss[2];
#pragma unroll
                    for (int q = 0; q < 2; ++q) { const uint2* orw = (const uint2*)(O16 + (size_t)rows[q] * DM) + lane; ss[q] = 0.f;
#pragma unroll
                        for (int j = 0; j < 4; ++j) { const uint2 w_ = orw[64 * j]; ov[q][j] = (f32x4){pg8::bf_lo(w_.x), pg8::bf_hi(w_.x), pg8::bf_lo(w_.y), pg8::bf_hi(w_.y)}; ss[q] += (ov[q][j].x * ov[q][j].x + ov[q][j].y * ov[q][j].y) + (ov[q][j].z * ov[q][j].z + ov[q][j].w * ov[q][j].w); } }
#pragma unroll
                    for (int o = 1; o < 64; o <<= 1) { ss[0] += __shfl_xor(ss[0], o); ss[1] += __shfl_xor(ss[1], o); }
#pragma unroll
                    for (int q = 0; q < 2; ++q) { const float rs = rsqrtf(ss[q] * (1.f / DM) + RMS_EPS);
                        f32x4* xo = (f32x4*)(out + (size_t)rows[q] * DM) + lane;
#pragma unroll
                        for (int j = 0; j < 4; ++j) { v[q][j] = v[q][j] + ov[q][j] * rs * postg[lane + 64 * j]; if (ok[q]) xo[64 * j] = v[q][j]; } }
                }
                if (!fin) {
                    float ss[2];
#pragma unroll
                    for (int q = 0; q < 2; ++q) { ss[q] = 0.f;
#pragma unroll
                        for (int j = 0; j < 4; ++j) ss[q] += (v[q][j].x * v[q][j].x + v[q][j].y * v[q][j].y) + (v[q][j].z * v[q][j].z + v[q][j].w * v[q][j].w); }
#pragma unroll
                    for (int o = 1; o < 64; o <<= 1) { ss[0] += __shfl_xor(ss[0], o); ss[1] += __shfl_xor(ss[1], o); }
                    float f[2];
#pragma unroll
                    for (int q = 0; q < 2; ++q) { const float rs = rsqrtf(ss[q] * (1.f / DM) + RMS_EPS);
                        unsigned long long* o8 = (unsigned long long*)(H + (size_t)rows[q] * DM) + lane;
#pragma unroll
                        for (int j = 0; j < 4; ++j) { v[q][j] = v[q][j] * rs * preg[lane + 64 * j];
                            if (ok[q]) o8[64 * j] = (unsigned long long)pk2(v[q][j].x, v[q][j].y) | ((unsigned long long)pk2(v[q][j].z, v[q][j].w) << 32); }
                        float d[8];
#pragma unroll
                        for (int hh = 0; hh < 8; ++hh) { float s_ = 0.f;
#pragma unroll
                            for (int j = 0; j < 4; ++j) { const f32x4 w = *(const LAS f32x4*)(wff + hh * 1024 + 4 * lane + 256 * j); s_ += (v[q][j].x * w.x + v[q][j].y * w.y) + (v[q][j].z * w.z + v[q][j].w * w.w); }
                            d[hh] = s_; }
                        float a4[4], c2[2];
                        const bool h5 = (lane & 32) != 0, h4 = (lane & 16) != 0, h3 = (lane & 8) != 0;
#pragma unroll
                        for (int i = 0; i < 4; ++i) { const float keep = h5 ? d[i + 4] : d[i], give = h5 ? d[i] : d[i + 4]; a4[i] = keep + __shfl_xor(give, 32); }
#pragma unroll
                        for (int i = 0; i < 2; ++i) { const float keep = h4 ? a4[i + 2] : a4[i], give = h4 ? a4[i] : a4[i + 2]; c2[i] = keep + __shfl_xor(give, 16); }
                        { const float keep = h3 ? c2[1] : c2[0], give = h3 ? c2[0] : c2[1]; f[q] = keep + __shfl_xor(give, 8); }
                        f[q] += __shfl_xor(f[q], 4); f[q] += __shfl_xor(f[q], 2); f[q] += __shfl_xor(f[q], 1);
                    }
#pragma unroll
                    for (int q = 0; q < 2; ++q) if (ok[q]) {
                        const int i = lane >> 3;
                        if ((lane & 7) == 0) { const float z = f[q] + bfg[i];
                            LOGF[(size_t)rows[q] * 8 + i] = fminf(z, 0.f) - log1pf(expf(-fabsf(z)));
                        } else if (l == 0 && (lane & 7) == 1) {
                            float invf = 1.0f;
                            invf = (i == 1) ? 0.19392274f : invf; invf = (i == 2) ? 0.03760603f : invf; invf = (i == 3) ? 0.0072926646f : invf; invf = (i == 4) ? 0.0014142136f : invf;
                            invf = (i == 5) ? 0.0002742482f : invf; invf = (i == 6) ? 5.3182957e-05f : invf; invf = (i == 7) ? 1.0313385e-05f : invf;
                            const float ang = (float)positions[rows[q]] * invf;
                            const float n = rintf(ang * 0.15915494309189535f);
                            float r = fmaf(-n, 6.2831854820251465f, ang); r = fmaf(-n, -1.7484555e-7f, r);
                            CS[(size_t)rows[q] * 16 + i] = __cosf(r); CS[(size_t)rows[q] * 16 + 8 + i] = __sinf(r);
                        }
                    }
                }
            }
        }
        __syncthreads();
        }
        if (fin) break;
        GSYNC();
        STAMP(0);
        if (PHM & 4) {
            int tid = threadIdx.x; asm volatile("" : "+v"(tid)); const int lane = tid & 63, wave = __builtin_amdgcn_readfirstlane(tid >> 6), gw = bx * NWAVES + wave; (void)lane; (void)gw;
            LAS float* sc = (LAS float*)ldsl;
            for (int bh = bx; bh < NB * 8; bh += G) {
                const int b = bh >> 3, hh = bh & 7; const int t0 = tid * 8;
                float v[8]; float run = 0.f;
#pragma unroll
                for (int e = 0; e < 8; ++e) { run += LOGF[((size_t)b * SEQ + t0 + e) * 8 + hh]; v[e] = run; }
                float incl = run;
#pragma unroll
                for (int o = 1; o < 64; o <<= 1) { const float n = __shfl_up(incl, o); if (lane >= o) incl += n; }
                if (lane == 63) sc[wave] = incl;
                __syncthreads();
                float base = incl - run;
                for (int w = 0; w < wave; ++w) base += sc[w];
                float* cn = CNEG + (size_t)bh * SEQ + t0;
#pragma unroll
                for (int e = 0; e < 8; ++e) cn[e] = -(base + v[e]) * 1.4426950408889634f;
                __syncthreads();
            }
            pg8::Gemm g{H, W1t, DM, DM, 0, 0}; pg8::StaticOrder S; S.init(T, PW, G, bx, WGM_B);
            pg8::EpiProj E{P, CS};
            for (int rep_ = 0; rep_ < REP_B; ++rep_) pg8::gemm_phase<pg8::EpiProj, pg8::StaticOrder, true, true>(ldsl, g, S, E);
        }
        GSYNC();
        STAMP(1);
        if (PHM & 8) {
            int tid = threadIdx.x; asm volatile("" : "+v"(tid)); const int lane = tid & 63, wave = __builtin_amdgcn_readfirstlane(tid >> 6), gw = bx * NWAVES + wave; (void)lane; (void)gw;
            const float* cw = (const float*)a.in[6] + (size_t)l * 3 * 512;
            for (int repx_ = (l == 0 ? REP_X : 1) - 1; repx_ >= 0; --repx_)
#pragma unroll 2
            for (int it = bx * NTHR + tid; it < T * 64; it += G * NTHR) {
                const int t = it >> 6, c8 = (it & 63) * 8, s = t & (SEQ - 1);
                bf16r* pr = P + (size_t)t * PW;
                const v4u cb = *(const v4u*)(pr + 4096 + c8), cg_ = *(const v4u*)(pr + 5632 + c8);
                const v4u zero = (v4u){0u, 0u, 0u, 0u};
                const v4u c0 = *(const v4u*)(pr + 4608 + c8), x0 = *(const v4u*)(pr + 5120 + c8);
                const v4u c1 = s >= 1 ? *(const v4u*)(pr - PW + 4608 + c8) : zero, x1 = s >= 1 ? *(const v4u*)(pr - PW + 5120 + c8) : zero;
                const v4u c2 = s >= 2 ? *(const v4u*)(pr - 2 * PW + 4608 + c8) : zero, x2 = s >= 2 ? *(const v4u*)(pr - 2 * PW + 5120 + c8) : zero;
                float k0[8], k1[8], k2[8];
#pragma unroll
                for (int q = 0; q < 2; ++q) { const f32x4 wa = *(const f32x4*)(cw + c8 + 4 * q), wb = *(const f32x4*)(cw + 512 + c8 + 4 * q), wc_ = *(const f32x4*)(cw + 1024 + c8 + 4 * q);
                    k0[4 * q] = wa.x; k0[4 * q + 1] = wa.y; k0[4 * q + 2] = wa.z; k0[4 * q + 3] = wa.w; k1[4 * q] = wb.x; k1[4 * q + 1] = wb.y; k1[4 * q + 2] = wb.z; k1[4 * q + 3] = wb.w;
                    k2[4 * q] = wc_.x; k2[4 * q + 1] = wc_.y; k2[4 * q + 2] = wc_.z; k2[4 * q + 3] = wc_.w; }
                v4u o;
#pragma unroll
                for (int e = 0; e < 4; ++e) {
                    const float ul0 = pg8::bf_lo(c0[e]) * pg8::bf_lo(x0[e]), uh0 = pg8::bf_hi(c0[e]) * pg8::bf_hi(x0[e]);
                    const float ul1 = pg8::bf_lo(c1[e]) * pg8::bf_lo(x1[e]), uh1 = pg8::bf_hi(c1[e]) * pg8::bf_hi(x1[e]);
                    const float ul2 = pg8::bf_lo(c2[e]) * pg8::bf_lo(x2[e]), uh2 = pg8::bf_hi(c2[e]) * pg8::bf_hi(x2[e]);
                    const float yl = pg8::bf_lo(cb[e]) * (k0[2 * e] * ul2 + k1[2 * e] * ul1 + k2[2 * e] * ul0) * silu_f(pg8::bf_lo(cg_[e]));
                    const float yh = pg8::bf_hi(cb[e]) * (k0[2 * e + 1] * uh2 + k1[2 * e + 1] * uh1 + k2[2 * e + 1] * uh0) * silu_f(pg8::bf_hi(cg_[e]));
                    o[e] = pk2(yl, yh);
                }
                if (repx_ > 0) *(v4u*)((bf16r*)out + (size_t)t * 512 + c8) = o; else *(v4u*)(pr + 4096 + c8) = o;
            }
            asm volatile("s_waitcnt vmcnt(0)" ::: "memory"); __syncthreads();
            const int NPAIR = NB * 16 * 8, PPW = (NPAIR + G - 1) / G;
            for (int rep_ = (l == 0 ? REP_C : 1) - 1; rep_ >= 0; --rep_)
            for (int pj = 0; pj < PPW; ++pj) {
                int b, u, s;
                if (G == 256) { const int j = vcu >> 5, w = vcu & 31; b = j >> 1; u = pj * 8 + (j & 1) * 4 + (w >> 3); s = w & 7; }
                else { const int pi = vcu * PPW + pj; if (pi >= NPAIR) break; const int bhu = pi >> 3; s = pi & 7; b = bhu >> 4; u = bhu & 15; }
                const attn_body::bf16* Pb = (const attn_body::bf16*)(P + (size_t)b * SEQ * PW);
                if (u < 8) {
                    const attn_body::bf16 *Qp = Pb + u * 64, *Kp = Pb + 512 + u * 64, *Vp = Pb + 1024 + u * 64; attn_body::bf16* Op = (attn_body::bf16*)Qp; int ldo = PW;
                    const float* bias = CNEG + (size_t)(b * 8 + u) * SEQ;
                    if (rep_ > 0) { Op = (attn_body::bf16*)out + (size_t)b * SEQ * 512 + u * 64; ldo = 512; }
#pragma unroll 1
                    for (int k = 0; k < 2; ++k) attn_body::attn_unit<8, true, false>(k ? 15 - s : s, Qp, Kp, Vp, Op, PW, ldo, bias, Pb + 1536 + u * 64, (char*)lds);
                } else {
                    const int d = u - 8, h = d >> 1, c = d & 1;
                    const attn_body::bf16 *Qp = Pb + 2048 + h * 128 + c * 64, *Kp = Pb + 2560 + h * 128 + c * 64, *Vp = Pb + 3072 + h * 128;
                    attn_body::bf16* Op = (attn_body::bf16*)(OD + (size_t)b * SEQ * DM) + c * 512 + h * 128;
#pragma unroll 1
                    for (int k = 0; k < 2; ++k) attn_body::attn_unit<8, false, true>(k ? 15 - s : s, Qp, Kp, Vp, Op, PW, DM, nullptr, nullptr, (char*)lds);
                }
            }
        }
        GSYNC();
        STAMP(2);
        if (PHM & 16) {
            int tid = threadIdx.x; asm volatile("" : "+v"(tid)); const int lane = tid & 63, wave = __builtin_amdgcn_readfirstlane(tid >> 6), gw = bx * NWAVES + wave; (void)lane; (void)gw;
            for (int repy_ = (l == 0 ? REP_Y : 1) - 1; repy_ >= 0; --repy_) {
            const float lam_init = 0.8f - 0.6f * expf(-0.3f * (float)l);
            const float p1 = ((const float*)a.in[7])[l * 64 + lane] * ((const float*)a.in[8])[l * 64 + lane], p2 = ((const float*)a.in[9])[l * 64 + lane] * ((const float*)a.in[10])[l * 64 + lane];
            const float lam = expf(wave_sum(p1)) - expf(wave_sum(p2)) + lam_init;
            const float* dgn = (const float*)a.in[11] + (size_t)l * 128;
            const int j0 = (lane & 15) * 8;
            const f32x4 ga = *(const f32x4*)(dgn + j0), gb = *(const f32x4*)(dgn + j0 + 4); const float gg[8] = {ga.x, ga.y, ga.z, ga.w, gb.x, gb.y, gb.z, gb.w};
#pragma unroll 4
            for (int it = gw; it < T; it += NGW) {
                const int t = it, h = lane >> 4; bf16r* pr = P + (size_t)t * PW; const bf16r* od = OD + (size_t)t * DM;
                const v4u o0 = *(const v4u*)(od + h * 128 + j0), o1 = *(const v4u*)(od + 512 + h * 128 + j0), dg = *(const v4u*)(pr + 3584 + h * 128 + j0);
                float dv[8]; float ss = 0.f;
#pragma unroll
                for (int e = 0; e < 4; ++e) { dv[2 * e] = pg8::bf_lo(o0[e]) - lam * pg8::bf_lo(o1[e]); dv[2 * e + 1] = pg8::bf_hi(o0[e]) - lam * pg8::bf_hi(o1[e]); ss += dv[2 * e] * dv[2 * e] + dv[2 * e + 1] * dv[2 * e + 1]; }
                ss += __shfl_xor(ss, 1); ss += __shfl_xor(ss, 2); ss += __shfl_xor(ss, 4); ss += __shfl_xor(ss, 8);
                const float rs = rsqrtf(ss * (1.f / 128.f) + RMS_EPS) * (1.f - lam_init);
                v4u o;
#pragma unroll
                for (int e = 0; e < 4; ++e) { const float g0 = gg[2 * e], g1 = gg[2 * e + 1];
                    o[e] = pk2(dv[2 * e] * rs * g0 * silu_f(pg8::bf_lo(dg[e])), dv[2 * e + 1] * rs * g1 * silu_f(pg8::bf_hi(dg[e]))); }
                if (repy_ > 0) *(v4u*)((bf16r*)out + (size_t)T * 512 + (size_t)t * 512 + h * 128 + j0) = o; else *(v4u*)(pr + 2048 + h * 128 + j0) = o;
            }
            }
            asm volatile("s_waitcnt vmcnt(0)" ::: "memory"); __syncthreads();
            pg8::Gemm g{H, Wmgt, DM, DM, 0, 0}; pg8::StaticOrder S; S.init(T, NMG, G, bx, WGM_G);
            pg8::EpiGate E{P, (const float*)a.in[5] + (size_t)l * NMG};
            for (int rep_ = 0; rep_ < REP_G; ++rep_) pg8::gemm_phase<pg8::EpiGate, pg8::StaticOrder, true, true>(ldsl, g, S, E);
        }
        GSYNC();
        STAMP(3);
        if (PHM & 32) {
            pg8::Gemm g{P, Wbrt, PW, 512, 2048, (size_t)512 * DM}; pg8::MergeOrder S; S.init(T, DM, G, bx);
            pg8::EpiMerge E{P, H};
            for (int rep_ = 0; rep_ < REP_D; ++rep_) pg8::gemm_phase<pg8::EpiMerge, pg8::MergeOrder, true, true>(ldsl, g, S, E);
        }
        GSYNC();
        STAMP(4);
        if (PHM & 64) {
            pg8::Gemm g{H, Wot, DM, DM, 0, 0}; pg8::StaticOrder S; S.init(T, DM, G, bx);
            pg8::EpiF32 E{O16};
            for (int rep_ = 0; rep_ < REP_E; ++rep_) pg8::gemm_phase<pg8::EpiF32, pg8::StaticOrder, true, true>(ldsl, g, S, E);
        }
        GSYNC();
        for (int rep_ = 0; rep_ < REP_S; ++rep_) GSYNC();
        STAMP(5);
    }
#ifdef PROBE_K
    GSYNC();
    if (bx == 0 && threadIdx.x == 0) out[0] = ts_acc * 0.1f;
#endif
#undef GSYNC
}

extern "C" void kernel_launch(void* const* d_in, const int* in_sizes, int n_in, void* d_out, int out_size, void* d_ws, size_t ws_size, hipStream_t stream) {
    static int grid = 0;
    if (grid == 0) {
        if (n_in != 17 || out_size != T * DM || ws_size < WS_END) { fprintf(stderr, "kernel_launch: unexpected shapes / workspace (n_in %d, out %d, ws %zu < %zu)\n", n_in, out_size, ws_size, (size_t)WS_END); grid = -1; return; }
        int dev = 0, cus = 0, per_cu = 0;
        hipGetDevice(&dev); hipDeviceGetAttribute(&cus, hipDeviceAttributeMultiprocessorCount, dev);
        hipFuncSetAttribute((const void*)fwd_megakernel, hipFuncAttributeMaxDynamicSharedMemorySize, LDS_BYTES);
        if (hipOccupancyMaxActiveBlocksPerMultiprocessor(&per_cu, (const void*)fwd_megakernel, NTHR, LDS_BYTES) != hipSuccess || per_cu < 1) per_cu = 1;
        (void)hipGetLastError();
        grid = cus * per_cu;
    }
    if (grid < 0) return;
    (void)hipMemsetAsync((char*)d_ws + WS_CTL, 0, CTL_BYTES, stream);
    Args a{};
    for (int i = 0; i < 17; ++i) a.in[i] = d_in[i];
    a.out = (float*)d_out; a.ws = (unsigned char*)d_ws;
    void* args[] = {&a};
    hipError_t e = hipLaunchCooperativeKernel((const void*)fwd_megakernel, dim3(grid), dim3(NTHR), args, LDS_BYTES, stream);
    if (e != hipSuccess) fprintf(stderr, "cooperative launch failed: %s (grid %d)\n", hipGetErrorString(e), grid);
}
```

```cpp
#include <hip/hip_runtime.h>
#include <cstdio>
#include <cstdint>
#ifndef PNROT
#define PNROT 1
#endif
namespace pg8 {
#define PG8_LAS __attribute__((address_space(3)))
typedef unsigned short bf16_t;
typedef short bf16x8 __attribute__((ext_vector_type(8)));
typedef float f32x4 __attribute__((ext_vector_type(4)));
typedef unsigned u32x4 __attribute__((ext_vector_type(4)));
constexpr int BM = 256, BK = 64, HALF = 128, HTB = HALF * BK * 2  , STAGE_BYTES = 8 * HTB, NXCD = 8;

__host__ __device__ __forceinline__ int lds_byte(int r, int c) { const int st = (r >> 4) * 2 + (c >> 5), rr = r & 15, cc = c & 31, ob = rr * 64 + cc * 2; return st * 1024 + (ob ^ (((ob >> 9) & 1) << 5)); }
__host__ __device__ __forceinline__ void stage_rc(int b, int& R, int& C) { const int st = b / 1024, sb = b % 1024, swz = sb ^ (((sb >> 9) & 1) << 5); R = (st >> 1) * 16 + swz / 64; C = (st & 1) * 32 + (swz % 64) / 2; }
__host__ __device__ __forceinline__ int perm32(int rho) { const int n = rho >> 4, i = rho & 15; return 8 * (i >> 2) + 4 * n + (i & 3); }

struct Unit { int pm, pn, z; };
struct Gemm { const bf16_t* A; const bf16_t* Bt; int lda, K; size_t Az, Bz; };

struct StaticOrder {
    int nM, nN, nwg, G, c, WGM;
    __host__ __device__ void init(int M, int N, int G_, int c_, int wgm = 2) { nM = M / BM; nN = N / BM; nwg = nM * nN; G = G_; c = c_; WGM = wgm; }
    __host__ __device__ bool next(int i, Unit& u) const {
        const long L = (long)i * G + c; if (L >= nwg) return false;
        int wgid = (int)L; { const int q = nwg / NXCD, r = nwg % NXCD, xcd = wgid % NXCD, off = wgid / NXCD; wgid = (xcd < r ? xcd * (q + 1) : r * (q + 1) + (xcd - r) * q) + off; }
        const int nig = WGM * nN, gid = wgid / nig, fm = gid * WGM, gsz = (nM - fm) < WGM ? (nM - fm) : WGM;
        u.pm = fm + ((wgid % nig) % gsz); u.pn = (wgid % nig) / gsz; u.z = 0;
        { const int rot = nN >= NXCD ? nN / NXCD : 1; u.pn = (u.pn + (int)(L % NXCD) * rot * PNROT) % nN; }
        return true;
    }
    __device__ __forceinline__ void a_ready(const Unit&) const {}
    __device__ __forceinline__ void done(const Unit&) const {}
};

__device__ __forceinline__ unsigned cvt_pk_bf16(float lo, float hi) { unsigned r; asm volatile("v_cvt_pk_bf16_f32 %0, %1, %2" : "=v"(r) : "v"(lo), "v"(hi)); return r; }
typedef float f32x2 __attribute__((ext_vector_type(2)));
constexpr int PW = 6144;
constexpr float QC2 = 0.125f * 1.4426950408889634f;
__device__ __forceinline__ float bf_lo(unsigned w) { return __uint_as_float(w << 16); }
__device__ __forceinline__ float bf_hi(unsigned w) { return __uint_as_float(w & 0xffff0000u); }

struct EpiProj {
    static constexpr bool PERM = true, AFTER_DRAIN = false;
    bf16_t* O; const float* cs;
    __device__ __forceinline__ bool operator()(f32x4 (&acc)[2][2][4][2], const Unit& u, int wr, int wc, int fr, int fq) const {
        const int row0 = u.pm * BM + wr * 64 + fr; const int col0 = u.pn * BM + wc * 32 + 8 * fq; const int pn = u.pn;
        const bool rot = (pn >= 8 && pn < 12) && ((wc & 1) == 0) && (fq < 2);
        const float sc = (pn < 2 || pn == 8 || pn == 9) ? QC2 : 1.f;
#pragma unroll
        for (int ai = 0; ai < 2; ++ai)
#pragma unroll
            for (int m = 0; m < 4; ++m) { const int row = row0 + ai * HALF + m * 16; bf16_t* rowp = O + (size_t)row * PW + col0;
                f32x4 c4 = (f32x4){1.f, 1.f, 1.f, 1.f}, s4 = (f32x4){0.f, 0.f, 0.f, 0.f};
                if (rot) { c4 = *(const f32x4*)(cs + (size_t)row * 16 + 4 * fq); s4 = *(const f32x4*)(cs + (size_t)row * 16 + 8 + 4 * fq); }
#pragma unroll
                for (int bj = 0; bj < 2; ++bj) { f32x4 v0 = acc[ai][bj][m][0], v1 = acc[ai][bj][m][1];
                    if (rot) { f32x4 a, b;
                        a[0] = v0[0] * c4[0] - v0[1] * s4[0]; a[1] = v0[1] * c4[0] + v0[0] * s4[0]; a[2] = v0[2] * c4[1] - v0[3] * s4[1]; a[3] = v0[3] * c4[1] + v0[2] * s4[1];
                        b[0] = v1[0] * c4[2] - v1[1] * s4[2]; b[1] = v1[1] * c4[2] + v1[0] * s4[2]; b[2] = v1[2] * c4[3] - v1[3] * s4[3]; b[3] = v1[3] * c4[3] + v1[2] * s4[3];
                        v0 = a; v1 = b; }
                    v0 = v0 * sc; v1 = v1 * sc; u32x4 w; w.x = cvt_pk_bf16(v0[0], v0[1]); w.y = cvt_pk_bf16(v0[2], v0[3]); w.z = cvt_pk_bf16(v1[0], v1[1]); w.w = cvt_pk_bf16(v1[2], v1[3]);
                    *(u32x4*)(rowp + bj * HALF) = w; }
                asm volatile("" ::: "memory"); }
        return false;
    }
};
struct EpiGate {
    static constexpr bool PERM = true, AFTER_DRAIN = false;
    bf16_t* O; const float* bias;
    __device__ __forceinline__ bool operator()(f32x4 (&acc)[2][2][4][2], const Unit& u, int wr, int wc, int fr, int fq) const {
        const int row0 = u.pm * BM + wr * 64 + fr; const int br = u.pn >> 2;
        const int col0 = 512 + br * 2048 + (u.pn & 3) * BM + wc * 32 + 8 * fq, bcol0 = u.pn * BM + wc * 32 + 8 * fq;
        f32x4 bv[2][2];
#pragma unroll
        for (int bj = 0; bj < 2; ++bj)
#pragma unroll
            for (int n = 0; n < 2; ++n) bv[bj][n] = *(const f32x4*)(bias + bcol0 + bj * HALF + 4 * n);
#pragma unroll
        for (int ai = 0; ai < 2; ++ai)
#pragma unroll
            for (int m = 0; m < 4; ++m) { bf16_t* rowp = O + (size_t)(row0 + ai * HALF + m * 16) * PW + col0;
#pragma unroll
                for (int bj = 0; bj < 2; ++bj) { const f32x4 v0 = acc[ai][bj][m][0] + bv[bj][0], v1 = acc[ai][bj][m][1] + bv[bj][1];
                    u32x4 w; w.x = cvt_pk_bf16(v0[0], v0[1]); w.y = cvt_pk_bf16(v0[2], v0[3]); w.z = cvt_pk_bf16(v1[0], v1[1]); w.w = cvt_pk_bf16(v1[2], v1[3]);
                    *(u32x4*)(rowp + bj * HALF) = w; }
                asm volatile("" ::: "memory"); }
        return false;
    }
};
struct EpiMerge {
    static constexpr bool PERM = true, AFTER_DRAIN = false;
    const bf16_t* Pg; bf16_t* Mo;
    __device__ __forceinline__ bool operator()(f32x4 (&acc)[2][2][4][2], const Unit& u, int wr, int wc, int fr, int fq) const {
        const int row0 = u.pm * BM + wr * 64 + fr; const int br = u.z;
        const int colg = 512 + br * 2048 + u.pn * BM + wc * 32 + 8 * fq, colm = u.pn * BM + wc * 32 + 8 * fq;
        const float L2E = 1.4426950408889634f;
#pragma unroll
        for (int ai = 0; ai < 2; ++ai)
#pragma unroll
            for (int m = 0; m < 4; ++m) { const size_t row = (size_t)(row0 + ai * HALF + m * 16);
#pragma unroll
                for (int bj = 0; bj < 2; ++bj) {
                    const u32x4 ga = *(const u32x4*)(Pg + row * PW + colg + bj * HALF);
                    u32x4 gb = (u32x4){0u, 0u, 0u, 0u}; if (br < 2) gb = *(const u32x4*)(Pg + row * PW + colg + 2048 + bj * HALF);
                    float f[8];
#pragma unroll
                    for (int e = 0; e < 4; ++e) { const unsigned wa = ga[e], wb = gb[e];
                        const float a0 = bf_lo(wa), a1 = bf_hi(wa), b0 = bf_lo(wb), b1 = bf_hi(wb);
                        const float ea0 = __builtin_amdgcn_exp2f(fminf(-a0 * L2E, 100.f)), ea1 = __builtin_amdgcn_exp2f(fminf(-a1 * L2E, 100.f));
                        float n0 = 1.f, n1 = 1.f; if (br < 2) { n0 = 1.f + __builtin_amdgcn_exp2f(fminf(-b0 * L2E, 100.f)); n1 = 1.f + __builtin_amdgcn_exp2f(fminf(-b1 * L2E, 100.f)); }
                        f[2 * e] = n0 * __builtin_amdgcn_rcpf(1.f + ea0); f[2 * e + 1] = n1 * __builtin_amdgcn_rcpf(1.f + ea1); }
                    f32x4 v0 = acc[ai][bj][m][0], v1 = acc[ai][bj][m][1];
                    v0[0] *= f[0]; v0[1] *= f[1]; v0[2] *= f[2]; v0[3] *= f[3]; v1[0] *= f[4]; v1[1] *= f[5]; v1[2] *= f[6]; v1[3] *= f[7];
                    acc[ai][bj][m][0] = v0; acc[ai][bj][m][1] = v1;
                    if (br == 2) { u32x4 w; w.x = cvt_pk_bf16(v0[0], v0[1]); w.y = cvt_pk_bf16(v0[2], v0[3]); w.z = cvt_pk_bf16(v1[0], v1[1]); w.w = cvt_pk_bf16(v1[2], v1[3]);
                        *(u32x4*)(Mo + row * 1024 + colm + bj * HALF) = w; } } }
        return br < 2;
    }
};
struct EpiF32 {
    static constexpr bool PERM = true, AFTER_DRAIN = false;
    bf16_t* O;
    __device__ __forceinline__ bool operator()(f32x4 (&acc)[2][2][4][2], const Unit& u, int wr, int wc, int fr, int fq) const {
        const int row0 = u.pm * BM + wr * 64 + fr; const int col0 = u.pn * BM + wc * 32 + 8 * fq;
#pragma unroll
        for (int ai = 0; ai < 2; ++ai)
#pragma unroll
            for (int m = 0; m < 4; ++m) { bf16_t* rowp = O + (size_t)(row0 + ai * HALF + m * 16) * 1024 + col0;
#pragma unroll
                for (int bj = 0; bj < 2; ++bj) { const f32x4 v0 = acc[ai][bj][m][0], v1 = acc[ai][bj][m][1];
                    u32x4 w; w.x = cvt_pk_bf16(v0[0], v0[1]); w.y = cvt_pk_bf16(v0[2], v0[3]); w.z = cvt_pk_bf16(v1[0], v1[1]); w.w = cvt_pk_bf16(v1[2], v1[3]);
                    *(u32x4*)(rowp + bj * HALF) = w; } }
        return false;
    }
};
struct MergeOrder {
    StaticOrder so;
    __host__ __device__ void init(int M, int N, int G_, int c_, int wgm = 2) { so.init(M, N, G_, c_, wgm); }
    __host__ __device__ bool next(int i, Unit& u) const { const int j = i / 3; if (!so.next(j, u)) return false; u.z = i - 3 * j; return true; }
    __device__ __forceinline__ void a_ready(const Unit&) const {}
    __device__ __forceinline__ void done(const Unit&) const {}
};


template <class Epi, class Sched, bool ALIGN_EPI = false, bool SP2 = false>
__device__ __forceinline__ void gemm_phase(PG8_LAS unsigned char* lds, const Gemm g, const Sched& S, const Epi& E) {
    int tid_ = threadIdx.x; asm volatile("" : "+v"(tid_));
    const int tid = tid_, wid = __builtin_amdgcn_readfirstlane(tid >> 6), lane = tid & 63, wr = wid >> 2, wc = wid & 3, fr = lane & 15, fq = lane >> 4;
    const int K = g.K, nt = K / BK;
    unsigned voffA[2], voffB[2];
#pragma unroll
    for (int i = 0; i < 2; ++i) { int R, C; stage_rc(tid * 16 + i * 8192, R, C); const int Rb = Epi::PERM ? ((R & ~31) + perm32(R & 31)) : R;
        voffA[i] = (unsigned)(R * g.lda + C) * 2u; voffB[i] = (unsigned)(Rb * K + C) * 2u; }
    const size_t kstep = (size_t)(BK * 2);
    const size_t hstepA = (size_t)HALF * g.lda * 2, hstepB = (size_t)HALF * K * 2;
    const size_t tstepA = 2 * hstepA, tstepB = 2 * hstepB;
    const unsigned ldsw = (unsigned)wid * 1024u;
    const int aoff = lds_byte(wr * 64 + fr, fq * 8), boff = lds_byte(wc * 32 + fr, fq * 8);
#define PG8_SA(b, h) (((b) * 2 + (h)) * HTB)
#define PG8_SB(b, h) ((4 + (b) * 2 + (h)) * HTB)
#define PG8_STAGE(bufoff, gbase, voff) do { _Pragma("unroll") for (int _i = 0; _i < 2; ++_i) \
        __builtin_amdgcn_global_load_lds((const unsigned*)((const char*)(gbase) + (voff)[_i]), (PG8_LAS unsigned*)(lds + (bufoff) + ldsw + _i * 8192), 16, 0, 0); } while (0)
#define PG8_LDA(dst, b, h) do { _Pragma("unroll") for (int m = 0; m < 4; ++m) _Pragma("unroll") for (int k = 0; k < 2; ++k) dst[m][k] = *(const PG8_LAS bf16x8*)(lds + PG8_SA(b, h) + aoff + m * 2048 + k * 1024); } while (0)
#define PG8_LDB(dst, b, h) do { _Pragma("unroll") for (int n = 0; n < 2; ++n) _Pragma("unroll") for (int k = 0; k < 2; ++k) dst[n][k] = *(const PG8_LAS bf16x8*)(lds + PG8_SB(b, h) + boff + n * 2048 + k * 1024); } while (0)
#define PG8_MMA(ai, bj, At, Bt) do { __builtin_amdgcn_s_setprio(1); _Pragma("unroll") for (int m = 0; m < 4; ++m) _Pragma("unroll") for (int n = 0; n < 2; ++n) _Pragma("unroll") for (int k = 0; k < 2; ++k) \
        acc[ai][bj][m][n] = __builtin_amdgcn_mfma_f32_16x16x32_bf16(Bt[n][k], At[m][k], acc[ai][bj][m][n], 0, 0, 0); __builtin_amdgcn_s_setprio(0); } while (0)
#define PG8_WAIT_V(n) asm volatile("s_waitcnt vmcnt(" #n ")" ::: "memory")
#define PG8_WAIT_L(n) asm volatile("s_waitcnt lgkmcnt(" #n ")" ::: "memory")
#define PG8_BAR __builtin_amdgcn_s_barrier()
#define PG8_SCHED __builtin_amdgcn_sched_barrier(0)
    Unit cur, nxt; int ui = 0;
    if (!S.next(0, cur)) return;
    f32x4 acc[2][2][4][2];
#pragma unroll
    for (int a = 0; a < 2; ++a)
#pragma unroll
        for (int b = 0; b < 2; ++b)
#pragma unroll
            for (int m = 0; m < 4; ++m)
#pragma unroll
                for (int n = 0; n < 2; ++n) acc[a][b][m][n] = (f32x4){0.f, 0.f, 0.f, 0.f};
    bf16x8 At[4][2], B0[2][2], B1[2][2];
    const char* cA = (const char*)(g.A + (size_t)cur.z * g.Az) + (size_t)cur.pm * tstepA; const char* cB = (const char*)(g.Bt + (size_t)cur.z * g.Bz) + (size_t)cur.pn * tstepB;
    S.a_ready(cur);
    if constexpr (SP2) {
        PG8_STAGE(PG8_SB(0, 0), cB, voffB); PG8_STAGE(PG8_SB(0, 1), cB + hstepB, voffB); PG8_STAGE(PG8_SA(0, 0), cA, voffA); PG8_STAGE(PG8_SA(0, 1), cA + hstepA, voffA);
        if (wr == 1) PG8_BAR;
        PG8_WAIT_V(2); PG8_BAR;
        PG8_STAGE(PG8_SB(1, 0), cB + kstep, voffB); PG8_STAGE(PG8_SA(1, 0), cA + kstep, voffA); PG8_STAGE(PG8_SB(1, 1), cB + hstepB + kstep, voffB);
        PG8_WAIT_V(6); PG8_BAR;
    } else {
        PG8_STAGE(PG8_SB(0, 0), cB, voffB); PG8_STAGE(PG8_SA(0, 0), cA, voffA); PG8_STAGE(PG8_SB(0, 1), cB + hstepB, voffB); PG8_STAGE(PG8_SA(0, 1), cA + hstepA, voffA);
        if (wr == 1) PG8_BAR;
        PG8_WAIT_V(4); PG8_BAR;
        PG8_STAGE(PG8_SB(1, 0), cB + kstep, voffB); PG8_STAGE(PG8_SA(1, 0), cA + kstep, voffA); PG8_STAGE(PG8_SB(1, 1), cB + hstepB + kstep, voffB);
        PG8_WAIT_V(6); PG8_BAR;
    }
    for (;;) {
        const bool has_next = S.next(ui + 1, nxt);
        const char* nA = has_next ? (const char*)(g.A + (size_t)nxt.z * g.Az) + (size_t)nxt.pm * tstepA : cA; const char* nB = has_next ? (const char*)(g.Bt + (size_t)nxt.z * g.Bz) + (size_t)nxt.pn * tstepB : cB;
        for (int t = 0; t < nt; t += 2) {
            const bool last = (t == nt - 2);
            const char* a1 = cA + (size_t)(t + 1) * kstep;
            const char* a2 = last ? nA : cA + (size_t)(t + 2) * kstep; const char* b2 = last ? nB : cB + (size_t)(t + 2) * kstep;
            const char* a3 = a2 + kstep; const char* b3 = b2 + kstep;
            if (last && has_next) S.a_ready(nxt);
            if constexpr (SP2) {
            PG8_LDB(B0, 0, 0); PG8_LDB(B1, 0, 1); PG8_SCHED; PG8_LDA(At, 0, 0); PG8_STAGE(PG8_SA(1, 1), a1 + hstepA, voffA);
            PG8_WAIT_V(8); PG8_WAIT_L(0); PG8_BAR; PG8_MMA(0, 0, At, B0); PG8_MMA(0, 1, At, B1); PG8_BAR; PG8_SCHED;
            PG8_LDA(At, 0, 1); PG8_STAGE(PG8_SB(0, 0), b2, voffB); PG8_STAGE(PG8_SB(0, 1), b2 + hstepB, voffB); PG8_STAGE(PG8_SA(0, 0), a2, voffA);
            PG8_WAIT_V(8); PG8_WAIT_L(0); PG8_BAR; PG8_MMA(1, 0, At, B0); PG8_MMA(1, 1, At, B1); PG8_BAR; PG8_SCHED;
            PG8_LDB(B0, 1, 0); PG8_LDB(B1, 1, 1); PG8_SCHED; PG8_LDA(At, 1, 0); PG8_STAGE(PG8_SA(0, 1), a2 + hstepA, voffA);
            PG8_WAIT_V(8); PG8_WAIT_L(0); PG8_BAR; PG8_MMA(0, 0, At, B0); PG8_MMA(0, 1, At, B1); PG8_BAR; PG8_SCHED;
            PG8_LDA(At, 1, 1); PG8_STAGE(PG8_SB(1, 0), b3, voffB); PG8_STAGE(PG8_SB(1, 1), b3 + hstepB, voffB); PG8_STAGE(PG8_SA(1, 0), a3, voffA);
            PG8_WAIT_V(8); PG8_WAIT_L(0); PG8_BAR; PG8_MMA(1, 0, At, B0); PG8_MMA(1, 1, At, B1); PG8_BAR; PG8_SCHED;
            } else {
            PG8_LDB(B0, 0, 0); PG8_SCHED; PG8_LDA(At, 0, 0); PG8_STAGE(PG8_SA(1, 1), a1 + hstepA, voffA);
            PG8_WAIT_L(8); PG8_BAR; PG8_WAIT_L(0); PG8_MMA(0, 0, At, B0); PG8_BAR; PG8_SCHED;
            PG8_LDB(B1, 0, 1); PG8_STAGE(PG8_SB(0, 0), b2, voffB);
            PG8_BAR; PG8_WAIT_L(0); PG8_MMA(0, 1, At, B1); PG8_BAR;
            PG8_LDA(At, 0, 1); PG8_STAGE(PG8_SA(0, 0), a2, voffA);
            PG8_BAR; PG8_WAIT_L(0); PG8_MMA(1, 0, At, B0); PG8_BAR; PG8_SCHED;
            PG8_STAGE(PG8_SB(0, 1), b2 + hstepB, voffB);
            PG8_WAIT_V(6); PG8_BAR; PG8_MMA(1, 1, At, B1); PG8_BAR;
            PG8_LDB(B0, 1, 0); PG8_SCHED; PG8_LDA(At, 1, 0); PG8_STAGE(PG8_SA(0, 1), a2 + hstepA, voffA);
            PG8_WAIT_L(8); PG8_BAR; PG8_WAIT_L(0); PG8_MMA(0, 0, At, B0); PG8_BAR; PG8_SCHED;
            PG8_LDB(B1, 1, 1); PG8_STAGE(PG8_SB(1, 0), b3, voffB);
            PG8_BAR; PG8_WAIT_L(0); PG8_MMA(0, 1, At, B1); PG8_BAR;
            PG8_LDA(At, 1, 1); PG8_STAGE(PG8_SA(1, 0), a3, voffA);
            PG8_BAR; PG8_WAIT_L(0); PG8_MMA(1, 0, At, B0); PG8_BAR; PG8_SCHED;
            PG8_STAGE(PG8_SB(1, 1), b3 + hstepB, voffB);
            PG8_WAIT_V(6); PG8_BAR; PG8_MMA(1, 1, At, B1); PG8_BAR;
            }
        }
        if constexpr (ALIGN_EPI) { if (wr == 0) PG8_BAR; }
        bool keep = false; if constexpr (!Epi::AFTER_DRAIN) { keep = E(acc, cur, wr, wc, fr, fq); S.done(cur); }
        if (!has_next) break;
        if (!keep)
#pragma unroll
        for (int a = 0; a < 2; ++a)
#pragma unroll
            for (int b = 0; b < 2; ++b)
#pragma unroll
                for (int m = 0; m < 4; ++m)
#pragma unroll
                    for (int n = 0; n < 2; ++n) acc[a][b][m][n] = (f32x4){0.f, 0.f, 0.f, 0.f};
        cur = nxt; cA = nA; cB = nB; ++ui;
        if constexpr (ALIGN_EPI) { if (wr == 1) PG8_BAR; }
    }
    PG8_WAIT_V(0);
    if constexpr (!ALIGN_EPI) { if (wr == 0) PG8_BAR; }
    PG8_BAR;
    if constexpr (Epi::AFTER_DRAIN) { E.fused(acc, cur, wr, wc, fr, fq, lds, wid, lane); S.done(cur); }
#undef PG8_SA
#undef PG8_SB
#undef PG8_STAGE
#undef PG8_LDA
#undef PG8_LDB
#undef PG8_MMA
#undef PG8_WAIT_V
#undef PG8_WAIT_L
#undef PG8_BAR
#undef PG8_SCHED
}
}

#ifndef PG8_SP2
#define PG8_SP2 true
#endif
#ifndef PG8_ALIGN
#define PG8_ALIGN true
#endif

#include <hip/hip_bf16.h>
#include <cmath>
namespace attn_body {
using bf16=__hip_bfloat16;
using bf16x8=__attribute__((ext_vector_type(8)))short;
using s16x4=__attribute__((ext_vector_type(4)))short;
using f32x16=__attribute__((ext_vector_type(16)))float;
using u32x4=__attribute__((ext_vector_type(4)))unsigned;
using f32x4v=__attribute__((ext_vector_type(4)))float;
constexpr int SEQ=4096,D=64;
constexpr int NW=8,QBLK=32,QB=QBLK*NW,KVBLK=64,NQB=SEQ/QB;
constexpr int ATTN_UNIT_ROWS=QB;
__device__ __forceinline__ int crow(int r,int hi){return (r&3)+8*(r>>2)+4*hi;}
#define SBAR() __builtin_amdgcn_sched_barrier(0)
__device__ __forceinline__ void cmask(f32x16&p0,f32x16&p1,int jb,int qrel,int hi){
  const float NEG=-INFINITY; int kb=64*jb+4*hi;
  #pragma unroll
  for(int r=0;r<16;++r){int kv=kb+(r&3)+8*(r>>2); if(kv>qrel)p0[r]=NEG; if(kv+32>qrel)p1[r]=NEG;}
}

constexpr int NSLOT=3, SLOTB=8192;
constexpr int LDS_K=0, LDS_V=NSLOT*SLOTB, LDS_WS=2*NSLOT*SLOTB, LDS_OST=LDS_WS+NW*64*4, LDS_BIAS=LDS_OST+NW*4096, LDS_BYTES=LDS_BIAS+SEQ*4;
constexpr float C2=0.125f*1.4426950408889634f;
__device__ __forceinline__ void glds16(const void*gsrc,unsigned lds_dst){unsigned keep;
  asm volatile("s_mov_b32 %0, m0\n\ts_mov_b32 m0, %2\n\ts_nop 0\n\tglobal_load_lds_dwordx4 %1, off\n\ts_mov_b32 m0, %0":"=&s"(keep):"v"(gsrc),"s"(lds_dst):"memory");}
__device__ __forceinline__ float max3f(float a,float b,float c){float r;asm("v_max3_f32 %0, %1, %2, %3":"=v"(r):"v"(a),"v"(b),"v"(c));return r;}
__device__ __forceinline__ float max2f(float a,float b){float r;asm("v_max_f32_e32 %0, %1, %2":"=v"(r):"v"(a),"v"(b));return r;}
__device__ __forceinline__ float fadd_s(float a,float b){float r;asm("v_add_f32_e32 %0, %1, %2":"=v"(r):"v"(a),"v"(b));return r;}
__device__ __forceinline__ float fsub_s(float a,float b){float r;asm("v_sub_f32_e32 %0, %1, %2":"=v"(r):"v"(a),"v"(b));return r;}
typedef float f32x2_t __attribute__((ext_vector_type(2))); typedef __bf16 bf16x2_t __attribute__((ext_vector_type(2)));
__device__ __forceinline__ unsigned cvtpk_s(float lo,float hi){f32x2_t v={lo,hi};bf16x2_t b=__builtin_convertvector(v,bf16x2_t);return __builtin_bit_cast(unsigned,b);}
#define WAIT_BAR(N) asm volatile("s_waitcnt vmcnt(" #N ") lgkmcnt(0)\n\ts_barrier":::"memory")

__device__ __forceinline__ void qkt(f32x16&p0,f32x16&p1,const char*Kslot,const bf16x8*qr,int r32,int hi){
  const char*kb=Kslot+hi*1024+r32*16;
  #pragma unroll
  for(int d0=0;d0<4;++d0){
    const bf16x8 b0=*reinterpret_cast<const bf16x8*>(kb+d0*2048);
    const bf16x8 b1=*reinterpret_cast<const bf16x8*>(kb+d0*2048+512);
    {p0=__builtin_amdgcn_mfma_f32_32x32x16_bf16(b0,qr[d0],p0,0,0,0);p1=__builtin_amdgcn_mfma_f32_32x32x16_bf16(b1,qr[d0],p1,0,0,0);}}
}
typedef __attribute__((address_space(3))) const char* lds_cptr;
typedef short v4i16_t __attribute__((ext_vector_type(4)));
__device__ __forceinline__ void kload8(bf16x8*kf,lds_cptr kp){
  kf[0]=*(const __attribute__((address_space(3))) bf16x8*)(kp);      kf[1]=*(const __attribute__((address_space(3))) bf16x8*)(kp+512);
  kf[2]=*(const __attribute__((address_space(3))) bf16x8*)(kp+2048); kf[3]=*(const __attribute__((address_space(3))) bf16x8*)(kp+2560);
  kf[4]=*(const __attribute__((address_space(3))) bf16x8*)(kp+4096); kf[5]=*(const __attribute__((address_space(3))) bf16x8*)(kp+4608);
  kf[6]=*(const __attribute__((address_space(3))) bf16x8*)(kp+6144); kf[7]=*(const __attribute__((address_space(3))) bf16x8*)(kp+6656);
}
__device__ __forceinline__ void kload2(bf16x8*kf,lds_cptr kp,int j){ kf[2*j]=*(const __attribute__((address_space(3))) bf16x8*)(kp+j*2048); kf[2*j+1]=*(const __attribute__((address_space(3))) bf16x8*)(kp+j*2048+512); }
__device__ __forceinline__ s16x4 vtr(lds_cptr p){ return __builtin_bit_cast(s16x4,__builtin_amdgcn_ds_read_tr16_b64_v4i16((__attribute__((address_space(3))) v4i16_t*)p)); }
__device__ __forceinline__ float rowmax(const f32x16&p0,const f32x16&p1){
  float a=max3f(p0[0],p0[1],p1[0]),b=max3f(p0[2],p0[3],p1[1]);a=max3f(a,p1[2],p1[3]);
  #pragma unroll
  for(int r=4;r<16;r+=4){a=max3f(a,p0[r],p0[r+1]);b=max3f(b,p0[r+2],p0[r+3]);a=max3f(a,p1[r],p1[r+1]);b=max3f(b,p1[r+2],p1[r+3]);}
  const float m=max2f(a,b);
  auto rr=__builtin_amdgcn_permlane32_swap(__float_as_uint(m),__float_as_uint(m),false,false);
  return max2f(__uint_as_float(rr[0]),__uint_as_float(rr[1]));
}
__device__ __forceinline__ void pv(f32x16*o,int vb,bf16x8 pa0,bf16x8 pa1,bf16x8 pa2,bf16x8 pa3){
  #pragma unroll
  for(int d0=0;d0<2;++d0){s16x4 lo[4],hi[4];
    #pragma unroll
    for(int ks=0;ks<4;++ks){
      asm volatile("ds_read_b64_tr_b16 %0,%1 offset:%c2":"=&v"(lo[ks]):"v"(vb),"i"(d0*4096+ks*1024):"memory");
      asm volatile("ds_read_b64_tr_b16 %0,%1 offset:%c2":"=&v"(hi[ks]):"v"(vb),"i"(d0*4096+ks*1024+512):"memory");}
    asm volatile("s_waitcnt lgkmcnt(0)":::"memory");SBAR();
    #define PK(k) (bf16x8){lo[k][0],lo[k][1],lo[k][2],lo[k][3],hi[k][0],hi[k][1],hi[k][2],hi[k][3]}
    o[d0]=__builtin_amdgcn_mfma_f32_32x32x16_bf16(pa0,PK(0),o[d0],0,0,0);
    o[d0]=__builtin_amdgcn_mfma_f32_32x32x16_bf16(pa1,PK(1),o[d0],0,0,0);
    o[d0]=__builtin_amdgcn_mfma_f32_32x32x16_bf16(pa2,PK(2),o[d0],0,0,0);
    o[d0]=__builtin_amdgcn_mfma_f32_32x32x16_bf16(pa3,PK(3),o[d0],0,0,0);
    #undef PK
  }
}

#ifndef ATTN_STORE16
#define ATTN_STORE16(p,v) (*(u32x4*)(p)=(v))
#endif
template<int THRL,bool HB,bool VW2> __device__ __forceinline__ void attn_unit(int qb,const bf16*Qp,const bf16*Kh,const bf16*Vh,bf16*Op,int ldq,int ldo,const float*biasg,const bf16*Gp,char*shm){
  int tid_=threadIdx.x; asm volatile("":"+v"(tid_)); const int tid=tid_,lane=tid&63,r32=lane&31,hi=lane>>5; const int wid=__builtin_amdgcn_readfirstlane(tid>>6);
  const int q0=qb*QB;
  constexpr int VS=VW2?2:1, L_WS=LDS_V+NSLOT*SLOTB*VS, L_OST=L_WS+NW*64*4, L_BIAS=L_OST+NW*4096;
  static_assert(!(HB&&VW2)&&L_BIAS+(HB?SEQ*4:0)<=131072,"attention LDS map");
  const bf16*Qw=Qp+(long)(q0+wid*QBLK)*ldq;
  const unsigned lds0=(unsigned)(uintptr_t)shm;
  float*wsf=(float*)(shm+L_WS)+wid*64;
  const bf16*ksrc=Kh+(long)lane*ldq+wid*8;
  const bf16*vsrc=Vh+(long)(16*(wid&3)+(lane>>2))*ldq+(wid>>2)*32+(lane&3)*8;
  const unsigned kdst=lds0+LDS_K+wid*1024, vdst=lds0+LDS_V+wid*1024;
  #define DMA_K(t,slot) glds16(ksrc+(long)(NT-1-(t))*KVBLK*ldq,(unsigned)__builtin_amdgcn_readfirstlane(kdst+(slot)))
  #define DMA_V(t,slot) do{ glds16(vsrc+(long)(NT-1-(t))*KVBLK*ldq,(unsigned)__builtin_amdgcn_readfirstlane(vdst+(slot)*VS)); \
    if(VW2) glds16(vsrc+(long)(NT-1-(t))*KVBLK*ldq+64,(unsigned)__builtin_amdgcn_readfirstlane(vdst+(slot)*VS+8192)); }while(0)
  const int vb0=(int)(lds0+LDS_V)+((lane>>4)&1)*32+(lane&3)*8+(4*hi+((lane&15)>>2))*64;
  const char*Kbase=shm+LDS_K; bf16x8 kf[8];
  const lds_cptr shm3=(lds_cptr)shm; const lds_cptr kp0=shm3+LDS_K+hi*1024+r32*16; const lds_cptr vp0=shm3+LDS_V+((lane>>4)&1)*32+(lane&3)*8+(4*hi+((lane&15)>>2))*64;
  const int NT=(q0+QB)/KVBLK;
  if(HB){ float*bl=(float*)(shm+L_BIAS); for(int i=tid;i<q0+QB;i+=NW*64) bl[i]=biasg[i]; }
  DMA_K(0,0);DMA_V(0,0);DMA_K(1,SLOTB);
  bf16x8 qr[4];
  #pragma unroll
  for(int d0=0;d0<4;++d0)qr[d0]=*reinterpret_cast<const bf16x8*>(&Qw[(long)r32*ldq+d0*16+hi*8]);
  float mhat=0.f,l_reg=0.f;f32x16 o[4];o[0]=f32x16{};o[1]=f32x16{};o[2]=f32x16{};o[3]=f32x16{};f32x16 negm=f32x16{};if(!HB&&!VW2)asm volatile("":"+v"(negm));
  const int qrel=wid*QBLK+r32;
  const lds_cptr bias3=shm3+L_BIAS+hi*16;
  #define BLD(P0,P1,tt) do{ const lds_cptr bp_=bias3+(NT-1-(tt))*256; \
    _Pragma("unroll") for(int g_=0;g_<4;++g_){ const f32x4v x_=*(const __attribute__((address_space(3))) f32x4v*)(bp_+32*g_); const f32x4v y_=*(const __attribute__((address_space(3))) f32x4v*)(bp_+128+32*g_); \
      P0[4*g_]=x_[0];P0[4*g_+1]=x_[1];P0[4*g_+2]=x_[2];P0[4*g_+3]=x_[3]; P1[4*g_]=y_[0];P1[4*g_+1]=y_[1];P1[4*g_+2]=y_[2];P1[4*g_+3]=y_[3]; } }while(0)
  #define BSUB(P0,P1) do{ _Pragma("unroll") for(int r=0;r<16;++r){P0[r]-=mhat;P1[r]-=mhat;} }while(0)
  #define CMASK(P0,P1,t) do{int jb_=3-(t); if(jb_>=0)cmask(P0,P1,jb_,qrel,hi);}while(0)
  bool resc=false;
  #define START(P0,P1) do{ const float rm=rowmax(P0,P1); resc=false; \
    if(__any(rm>(float)THRL)){ const float dl=__builtin_fmaxf(rm,0.f); mhat=fadd_s(mhat,dl); \
      _Pragma("unroll") for(int r=0;r<16;++r){P0[r]=fsub_s(P0[r],dl);P1[r]=fsub_s(P1[r],dl);} \
      if(!HB&&!VW2){ _Pragma("unroll") for(int r=0;r<16;++r)negm[r]=-mhat; asm volatile("":"+v"(negm)); } } \
    _Pragma("unroll") for(int r=0;r<16;++r)P0[r]=__builtin_amdgcn_exp2f(P0[r]); }while(0)
  #define RESC() do{ if(resc){ asm volatile("s_waitcnt lgkmcnt(0)":::"memory"); \
      _Pragma("unroll") for(int d_=0;d_<2*VS;++d_) _Pragma("unroll") for(int r=0;r<16;++r)o[d_][r]*=wsf[crow(r,hi)]; } }while(0)
  f32x16 pA0,pA1,pB0,pB1;
  int sl_prev=0,sl_cur=0,sl_next=SLOTB;
  #define ROT() do{sl_prev=sl_cur;sl_cur=sl_next;sl_next=(sl_next==(NSLOT-1)*SLOTB)?0:sl_next+SLOTB;}while(0)
  DMA_K(2,2*SLOTB);
  #define WB3() do{ if(VW2){WAIT_BAR(4);}else{WAIT_BAR(3);} }while(0)
  #define WB2() do{ if(VW2){WAIT_BAR(3);}else{WAIT_BAR(2);} }while(0)
  #define WB1() do{ if(VW2){WAIT_BAR(2);}else{WAIT_BAR(1);} }while(0)
  WB3();
  if(HB){BLD(pA0,pA1,0);}else if(VW2){pA0=f32x16{};pA1=f32x16{};}else{pA0=negm;pA1=negm;}
  qkt(pA0,pA1,Kbase,qr,r32,hi);asm volatile("s_nop 15\n\ts_nop 7":"+v"(pA0),"+v"(pA1));CMASK(pA0,pA1,0);
  START(pA0,pA1);
  if(HB){BLD(pB0,pB1,1); BSUB(pB0,pB1);}
  _Pragma("unroll") for(int r=0;r<16;++r)pA1[r]=__builtin_amdgcn_exp2f(pA1[r]);
  WAIT_BAR(0);
  DMA_K(3,0);DMA_V(1,SLOTB);
  ROT();
  kload8(kf,kp0+sl_cur);
  WB2();
  s16x4 vlo[8],vhi[8]; u32x4 pw0,pw1,pw2,pw3;
  #define PKW(P,B) cvtpk_s(P[B],P[B+1])
  #define PAF(k) __builtin_bit_cast(bf16x8,pw##k)
  #define VFR(i) (bf16x8){vlo[i][0],vlo[i][1],vlo[i][2],vlo[i][3],vhi[i][0],vhi[i][1],vhi[i][2],vhi[i][3]}
  #define PIN(x) asm volatile("":"+v"(x))
  #define MX3(a,b,c) __builtin_fmaxf(__builtin_fmaxf((a),(b)),(c))
  #define GAPA(MF,A0,A1,A2,A3,W0,W1,PW) do{ MF; sacc+=A0; sacc+=A1; sacc+=A2; sacc+=A3; PIN(sacc); W0; W1; PIN(PW); SBAR(); }while(0)
  #define EX(v) __builtin_amdgcn_exp2f(v)
  #define GAPB(MF,X,B) do{ MF; X[B]=EX(X[B]); X[B+1]=EX(X[B+1]); X[B+2]=EX(X[B+2]); X[B+3]=EX(X[B+3]); PIN(X); SBAR(); }while(0)
  #define GAPB2(MF,X,B) do{ MF; X[B]=EX(X[B]); X[B+1]=EX(X[B+1]); PIN(X); SBAR(); }while(0)
  #define VRD(i) do{ vlo[i]=vtr(vp_+(((i)>>2)*4096+((i)&3)*1024)); vhi[i]=vtr(vp_+(((i)>>2)*4096+((i)&3)*1024+512)); }while(0)
  #define VRDH(i) do{ vlo[i]=vtr(vp_+8192+(((i)>>2)*4096+((i)&3)*1024)); vhi[i]=vtr(vp_+8192+(((i)>>2)*4096+((i)&3)*1024+512)); }while(0)
  #define KRD(G,j) do{ if(G){ kload2(kf,kp0+sl_next,j); SBAR(); } }while(0)
  #define STEP(C0,C1,P0,P1,t,GK,GV,GL) do{ SBAR(); \
    const lds_cptr vp_=vp0+sl_prev*VS; \
    if(VW2){ const float nm_=-mhat; _Pragma("unroll") for(int r=0;r<16;++r){C0[r]=nm_;C1[r]=nm_;} } \
    VRD(0); SBAR(); float sacc=(P0[0]+P0[1]); \
    GAPA(C0=__builtin_amdgcn_mfma_f32_32x32x16_bf16(kf[0],qr[0],(HB||VW2)?C0:negm,0,0,0), P0[2],P0[3],P0[4],P0[5],     pw0[0]=PKW(P0,0), pw0[1]=PKW(P0,2), pw0); \
    VRD(4); SBAR(); GAPA(C1=__builtin_amdgcn_mfma_f32_32x32x16_bf16(kf[1],qr[0],(HB||VW2)?C1:negm,0,0,0), P0[6],P0[7],P0[8],P0[9],     pw0[2]=PKW(P0,4), pw0[3]=PKW(P0,6), pw0); \
    VRD(1); SBAR(); GAPA(C0=__builtin_amdgcn_mfma_f32_32x32x16_bf16(kf[2],qr[1],C0,0,0,0),   P0[10],P0[11],P0[12],P0[13], pw1[0]=PKW(P0,8), pw1[1]=PKW(P0,10), pw1); \
    VRD(5); SBAR(); GAPA(C1=__builtin_amdgcn_mfma_f32_32x32x16_bf16(kf[3],qr[1],C1,0,0,0),   P0[14],P0[15],P1[0],P1[1],   pw1[2]=PKW(P0,12),pw1[3]=PKW(P0,14), pw1); \
    VRD(2); SBAR(); GAPA(C0=__builtin_amdgcn_mfma_f32_32x32x16_bf16(kf[4],qr[2],C0,0,0,0),   P1[2],P1[3],P1[4],P1[5],     pw2[0]=PKW(P1,0), pw2[1]=PKW(P1,2), pw2); \
    VRD(6); SBAR(); GAPA(C1=__builtin_amdgcn_mfma_f32_32x32x16_bf16(kf[5],qr[2],C1,0,0,0),   P1[6],P1[7],P1[8],P1[9],     pw2[2]=PKW(P1,4), pw2[3]=PKW(P1,6), pw2); \
    VRD(3); SBAR(); GAPA(C0=__builtin_amdgcn_mfma_f32_32x32x16_bf16(kf[6],qr[3],C0,0,0,0),   P1[10],P1[11],P1[12],P1[13], pw3[0]=PKW(P1,8), pw3[1]=PKW(P1,10), pw3); \
    VRD(7); SBAR(); GAPA(C1=__builtin_amdgcn_mfma_f32_32x32x16_bf16(kf[7],qr[3],C1,0,0,0),   P1[14],P1[15],0.f,0.f,       pw3[2]=PKW(P1,12),pw3[3]=PKW(P1,14), pw3); \
    l_reg+=sacc; \
    if(GK){DMA_K((t)+3,sl_cur);} if(GV){DMA_V((t)+1,sl_next);} \
    CMASK(C0,C1,t); \
    { float a=MX3(C0[0],C0[1],C1[0]),b=MX3(C0[2],C0[3],C1[1]); a=MX3(a,C1[2],C1[3]); \
      _Pragma("unroll") for(int r=4;r<16;r+=4){a=MX3(a,C0[r],C0[r+1]);b=MX3(b,C0[r+2],C0[r+3]);a=MX3(a,C1[r],C1[r+1]);b=MX3(b,C1[r+2],C1[r+3]);} \
      float rm=__builtin_fmaxf(a,b); { auto rr=__builtin_amdgcn_permlane32_swap(__float_as_uint(rm),__float_as_uint(rm),false,false); rm=__builtin_fmaxf(__uint_as_float(rr[0]),__uint_as_float(rr[1])); } \
      resc=false; \
      if(__builtin_expect(__any(rm>(float)THRL),0)){ const float dl=__builtin_fmaxf(rm,0.f); mhat+=dl; \
        _Pragma("unroll") for(int r=0;r<16;++r){C0[r]-=dl;C1[r]-=dl;} \
        if(!HB&&!VW2){ _Pragma("unroll") for(int r=0;r<16;++r)negm[r]=-mhat; asm volatile("":"+v"(negm)); } \
        const float f=__builtin_amdgcn_exp2f(-dl); l_reg*=f; if(hi==0)wsf[r32]=f; resc=true; } } \
    SBAR(); \
    if(HB&&(GL)){ BLD(P0,P1,(t)+1); SBAR(); } \
    if(!VW2){ \
    GAPB(o[0]=__builtin_amdgcn_mfma_f32_32x32x16_bf16(PAF(0),VFR(0),o[0],0,0,0), C0,0); \
    GAPB(o[1]=__builtin_amdgcn_mfma_f32_32x32x16_bf16(PAF(0),VFR(4),o[1],0,0,0), C0,4); \
    KRD(GL,0); GAPB(o[0]=__builtin_amdgcn_mfma_f32_32x32x16_bf16(PAF(1),VFR(1),o[0],0,0,0), C0,8); \
    KRD(GL,1); GAPB(o[1]=__builtin_amdgcn_mfma_f32_32x32x16_bf16(PAF(1),VFR(5),o[1],0,0,0), C0,12); \
    KRD(GL,2); GAPB(o[0]=__builtin_amdgcn_mfma_f32_32x32x16_bf16(PAF(2),VFR(2),o[0],0,0,0), C1,0); \
    KRD(GL,3); GAPB(o[1]=__builtin_amdgcn_mfma_f32_32x32x16_bf16(PAF(2),VFR(6),o[1],0,0,0), C1,4); \
    GAPB(o[0]=__builtin_amdgcn_mfma_f32_32x32x16_bf16(PAF(3),VFR(3),o[0],0,0,0), C1,8); \
    GAPB(o[1]=__builtin_amdgcn_mfma_f32_32x32x16_bf16(PAF(3),VFR(7),o[1],0,0,0), C1,12); \
    } else {   \
    GAPB2(o[0]=__builtin_amdgcn_mfma_f32_32x32x16_bf16(PAF(0),VFR(0),o[0],0,0,0), C0,0); VRDH(0); SBAR(); \
    GAPB2(o[1]=__builtin_amdgcn_mfma_f32_32x32x16_bf16(PAF(0),VFR(4),o[1],0,0,0), C0,2); VRDH(4); SBAR(); \
    KRD(GL,0); GAPB2(o[0]=__builtin_amdgcn_mfma_f32_32x32x16_bf16(PAF(1),VFR(1),o[0],0,0,0), C0,4); VRDH(1); SBAR(); \
    KRD(GL,1); GAPB2(o[1]=__builtin_amdgcn_mfma_f32_32x32x16_bf16(PAF(1),VFR(5),o[1],0,0,0), C0,6); VRDH(5); SBAR(); \
    KRD(GL,2); GAPB2(o[0]=__builtin_amdgcn_mfma_f32_32x32x16_bf16(PAF(2),VFR(2),o[0],0,0,0), C0,8); VRDH(2); SBAR(); \
    KRD(GL,3); GAPB2(o[1]=__builtin_amdgcn_mfma_f32_32x32x16_bf16(PAF(2),VFR(6),o[1],0,0,0), C0,10); VRDH(6); SBAR(); \
    GAPB2(o[0]=__builtin_amdgcn_mfma_f32_32x32x16_bf16(PAF(3),VFR(3),o[0],0,0,0), C0,12); VRDH(3); SBAR(); \
    GAPB2(o[1]=__builtin_amdgcn_mfma_f32_32x32x16_bf16(PAF(3),VFR(7),o[1],0,0,0), C0,14); VRDH(7); SBAR(); \
    GAPB2(o[2]=__builtin_amdgcn_mfma_f32_32x32x16_bf16(PAF(0),VFR(0),o[2],0,0,0), C1,0); \
    GAPB2(o[3]=__builtin_amdgcn_mfma_f32_32x32x16_bf16(PAF(0),VFR(4),o[3],0,0,0), C1,2); \
    GAPB2(o[2]=__builtin_amdgcn_mfma_f32_32x32x16_bf16(PAF(1),VFR(1),o[2],0,0,0), C1,4); \
    GAPB2(o[3]=__builtin_amdgcn_mfma_f32_32x32x16_bf16(PAF(1),VFR(5),o[3],0,0,0), C1,6); \
    GAPB2(o[2]=__builtin_amdgcn_mfma_f32_32x32x16_bf16(PAF(2),VFR(2),o[2],0,0,0), C1,8); \
    GAPB2(o[3]=__builtin_amdgcn_mfma_f32_32x32x16_bf16(PAF(2),VFR(6),o[3],0,0,0), C1,10); \
    GAPB2(o[2]=__builtin_amdgcn_mfma_f32_32x32x16_bf16(PAF(3),VFR(3),o[2],0,0,0), C1,12); \
    GAPB2(o[3]=__builtin_amdgcn_mfma_f32_32x32x16_bf16(PAF(3),VFR(7),o[3],0,0,0), C1,14); \
    } \
    if(HB&&(GL)){ BSUB(P0,P1); } \
    }while(0)
  int t=1;
  #undef CMASK
  #define CMASK(P0,P1,t) do{int jb_=3-(t); if(jb_>=0)cmask(P0,P1,jb_,qrel,hi);}while(0)
  for(;t+5<NT;t+=2){
    STEP(pB0,pB1,pA0,pA1,t,true,true,true);     WB2(); RESC(); ROT();
    STEP(pA0,pA1,pB0,pB1,t+1,true,true,true);   WB2(); RESC(); ROT();
  }
  #undef CMASK
  #define CMASK(P0,P1,t) do{int jb_=3-(t); if(jb_>=0)cmask(P0,P1,jb_,qrel,hi);}while(0)
  #define ENDW(tt) do{ if((tt)+3<NT){WB2();} else if((tt)+2<NT){WB1();} else {WAIT_BAR(0);} }while(0)
  for(;t+1<NT;t+=2){
    STEP(pB0,pB1,pA0,pA1,t,(t+3<NT),(t+1<NT),(t+1<NT));       ENDW(t);   RESC(); ROT();
    STEP(pA0,pA1,pB0,pB1,t+1,(t+4<NT),(t+2<NT),(t+2<NT));     ENDW(t+1); RESC(); ROT();
  }
  STEP(pB0,pB1,pA0,pA1,NT-1,false,false,false); RESC();
  { float sacc=pB0[0]+pB0[1]; _Pragma("unroll") for(int r=2;r<16;++r)sacc+=pB0[r]; _Pragma("unroll") for(int r=0;r<16;++r)sacc+=pB1[r]; l_reg+=sacc;
    pw0=(u32x4){PKW(pB0,0),PKW(pB0,2),PKW(pB0,4),PKW(pB0,6)};pw1=(u32x4){PKW(pB0,8),PKW(pB0,10),PKW(pB0,12),PKW(pB0,14)};pw2=(u32x4){PKW(pB1,0),PKW(pB1,2),PKW(pB1,4),PKW(pB1,6)};pw3=(u32x4){PKW(pB1,8),PKW(pB1,10),PKW(pB1,12),PKW(pB1,14)};
    SBAR(); pv(o,vb0+sl_cur*VS,PAF(0),PAF(1),PAF(2),PAF(3)); if(VW2){ SBAR(); pv(o+2,vb0+sl_cur*VS+8192,PAF(0),PAF(1),PAF(2),PAF(3)); } }
  #undef PKW
  #undef PAF
  #undef VFR
  #undef PIN
  #undef MX3
  #undef GAPA
  #undef GAPB
  #undef GAPB2
  #undef EX
  #undef VRD
  #undef VRDH
  #undef KRD
  #undef STEP
  #undef ENDW
  {auto rr=__builtin_amdgcn_permlane32_swap(__float_as_uint(l_reg),__float_as_uint(l_reg),false,false);l_reg=__uint_as_float(rr[0])+__uint_as_float(rr[1]);}
  if(hi==0)wsf[32+r32]=l_reg;asm volatile("s_waitcnt lgkmcnt(0)":::"memory");
  u32x4 gt[4];
  if(HB){ const bf16*Gw=Gp+(long)(q0+wid*QBLK)*ldq;
    #pragma unroll
    for(int i=0;i<4;++i)gt[i]=*(const u32x4*)(Gw+(long)(i*8+(lane>>3))*ldq+(lane&7)*8); }
  float rli[16];
  #pragma unroll
  for(int r=0;r<16;++r)rli[r]=__builtin_amdgcn_rcpf(wsf[32+crow(r,hi)]);
  bf16*Ow=Op+(long)(q0+wid*QBLK)*ldo;
  { bf16*stg=(bf16*)(shm+L_OST)+wid*2048;
    #pragma unroll
    for(int hv=0;hv<VS;++hv){
    #pragma unroll
    for(int r=0;r<16;++r){const int orow=crow(r,hi);
      #pragma unroll
      for(int d0=0;d0<2;++d0)stg[orow*64+d0*32+r32]=__float2bfloat16(o[2*hv+d0][r]*rli[r]);}
    asm volatile("s_waitcnt lgkmcnt(0)":::"memory");
    #pragma unroll
    for(int i=0;i<4;++i){const int row=i*8+(lane>>3),ch=lane&7; u32x4 v=*(const u32x4*)(stg+row*64+ch*8);
      if(HB){ _Pragma("unroll") for(int e=0;e<4;++e){ const float ol=__uint_as_float(v[e]<<16),oh=__uint_as_float(v[e]&0xffff0000u),gl=__uint_as_float(gt[i][e]<<16),gh=__uint_as_float(gt[i][e]&0xffff0000u);
          const float sl=gl*__builtin_amdgcn_rcpf(1.f+__builtin_amdgcn_exp2f(fminf(-gl*1.4426950408889634f,100.f))),sh=gh*__builtin_amdgcn_rcpf(1.f+__builtin_amdgcn_exp2f(fminf(-gh*1.4426950408889634f,100.f)));
          v[e]=cvtpk_s(ol*sl,oh*sh); } }
      ATTN_STORE16(Ow+(long)row*ldo+hv*64+ch*8,v);}
    asm volatile("s_waitcnt lgkmcnt(0)":::"memory"); } }
  asm volatile("s_waitcnt lgkmcnt(0)\n\ts_barrier":::"memory");
  #undef BLD
  #undef BSUB
  #undef DMA_K
  #undef DMA_V
  #undef CMASK
  #undef START
  #undef RESC
  #undef ROT
  #undef WB3
  #undef WB2
  #undef WB1
}
constexpr int ATTN_LDS_BYTES=LDS_BYTES;
#undef SBAR
#undef WAIT_BAR
}


#include <hip/hip_cooperative_groups.h>
namespace cg = cooperative_groups;
#define LAS __attribute__((address_space(3)))
typedef unsigned short bf16r;
typedef unsigned v4u __attribute__((ext_vector_type(4)));
typedef float f32x4 __attribute__((ext_vector_type(4)));

constexpr int NWAVES = 8, NTHR = 512;
constexpr int NB = 4, SEQ = 4096, DM = 1024, T = NB * SEQ, DEPTH = 2, INW = 9224, PW = pg8::PW, NMG = 3072;
constexpr float RMS_EPS = 1e-6f;
constexpr size_t MiB = 1u << 20;
constexpr size_t WS_CTL = 0, CTL_BYTES = 65536;
constexpr size_t WS_LOGF = 2 * MiB;
constexpr size_t WS_CNEG = 2 * MiB + 512 * 1024;
constexpr size_t WS_CS = 3 * MiB;
constexpr size_t WS_W1 = 4 * MiB;
constexpr size_t WS_WMG = 16 * MiB;
constexpr size_t WS_WBR = 22 * MiB;
constexpr size_t WS_WO = 25 * MiB;
constexpr size_t WS_H = 28 * MiB;
constexpr size_t WS_OD = 60 * MiB;
constexpr size_t WS_P = 92 * MiB;
constexpr size_t WS_END = 284 * MiB;
constexpr int LDS_BYTES = 131072 + 256, LDS_MISC = 131072;
#ifndef PHM
#define PHM 127
#endif
#ifndef WGM_B
#define WGM_B 2
#endif
#ifndef WGM_G
#define WGM_G 2
#endif
#ifndef REP_A
#define REP_A 1
#endif
#ifndef REP_B
#define REP_B 1
#endif
#ifndef REP_W
#define REP_W 1
#endif
#ifndef REP_X
#define REP_X 1
#endif
#ifndef REP_Y
#define REP_Y 1
#endif
#ifndef REP_C
#define REP_C 1
#endif
#ifndef REP_G
#define REP_G 1
#endif
#ifndef REP_D
#define REP_D 1
#endif
#ifndef REP_E
#define REP_E 1
#endif
#ifndef REP_S
#define REP_S 0
#endif

__device__ __forceinline__ unsigned pk2(float lo, float hi) { return pg8::cvt_pk_bf16(lo, hi); }
__device__ __forceinline__ float wave_sum(float v) {
#pragma unroll
    for (int o = 1; o < 64; o <<= 1) v += __shfl_xor(v, o);
    return v;
}
__device__ __forceinline__ float silu_f(float v) { return v * __builtin_amdgcn_rcpf(1.f + __builtin_amdgcn_exp2f(fminf(-v * 1.4426950408889634f, 100.f))); }

template <int MODE> __device__ __forceinline__ int cmap(int n) {
    if (MODE == 1) {
        int o = n + (n >= 1536 ? 8 : 0);
        if (n >= 2048 && n < 3072) { const int w = n & 63; if (w < 16) o = (n & ~63) + 8 + ((w & 1) ? 8 + (w >> 1) : (w >> 1)); }
        return o;
    }
    if (MODE == 2) return 6152 + n;
    return n;
}
template <int MODE> __device__ __forceinline__ void transpose_item(const float* W, int ldw, int K, int N, bf16r* WT, LAS float* scr, int item, int lane) {
    const int nblk = N / 32, kb = item / nblk, nb = item % nblk, k0 = 64 * kb, n0 = 32 * nb;
    const int oc = cmap<MODE>(n0 + (lane & 31));
#pragma unroll
    for (int i = 0; i < 32; ++i) { const int kk = 2 * i + (lane >> 5); scr[kk * 33 + (lane & 31)] = W[(size_t)(k0 + kk) * ldw + oc]; }
    asm volatile("s_waitcnt lgkmcnt(0)" ::: "memory");
    const int c = lane & 7;
#pragma unroll
    for (int j = 0; j < 4; ++j) { const int n = (lane >> 3) + 8 * j; const LAS float* s = scr + (8 * c) * 33 + n;
        v4u o; o.x = pk2(s[0 * 33], s[1 * 33]); o.y = pk2(s[2 * 33], s[3 * 33]); o.z = pk2(s[4 * 33], s[5 * 33]); o.w = pk2(s[6 * 33], s[7 * 33]);
        *(v4u*)(WT + (size_t)(n0 + n) * K + k0 + 8 * c) = o; }
    asm volatile("s_waitcnt lgkmcnt(0)" ::: "memory");
}

#define XB_TMO      128
#define XB_XCNT(j)  (256  + 64 * (j))
#define XB_XSUB(j)  (1280 + 64 * (j))
#define XB_XGEN(j)  (2304 + 64 * (j))
#define XB_TOP      3328
#define XB_TOPGEN   3392
#define XCD_BAR_WORDS 3456
#define XB_SPIN_CAP (1u << 18)

__device__ __forceinline__ unsigned xb_ld(unsigned* p)              { return __hip_atomic_load(p, __ATOMIC_RELAXED, __HIP_MEMORY_SCOPE_AGENT); }
__device__ __forceinline__ unsigned xb_add(unsigned* p, unsigned v) { return __hip_atomic_fetch_add(p, v, __ATOMIC_RELAXED, __HIP_MEMORY_SCOPE_AGENT); }
__device__ __forceinline__ unsigned xb_xcc_id() { return (unsigned)__builtin_amdgcn_s_getreg((3 << 11) | 20) & 0xFu; }
#define XB_SPIN(cond, bar) do { unsigned _sp = 0; while (cond) { __builtin_amdgcn_s_sleep(1); \
    if ((++_sp & 255u) == 0u) { if (xb_ld(&(bar)[XB_TMO])) break; if (_sp > XB_SPIN_CAP) { atomicAdd(&(bar)[XB_TMO], 1u); break; } } } } while (0)

struct XcdBarrier {
    unsigned* bar; unsigned x;
    volatile LAS unsigned* st;
};

__device__ __forceinline__ XcdBarrier xcd_barrier_post(unsigned* bar, volatile LAS unsigned* st) {
    XcdBarrier b; b.bar = bar; b.x = xb_xcc_id(); b.st = st;
    if (threadIdx.x == 0) (void)xb_add(&bar[XB_XCNT(b.x)], 1u);
    return b;
}
__device__ __forceinline__ void xcd_barrier_complete(unsigned* bar, unsigned x, unsigned& nloc, unsigned& nx) {
    const unsigned G = gridDim.x * gridDim.y * gridDim.z;
    unsigned sum, cnt, mine, sp = 0u;
    for (;;) {
        sum = 0u; cnt = 0u; mine = 0u;
#pragma unroll
        for (unsigned j = 0; j < 16; ++j) { const unsigned c = xb_ld(&bar[XB_XCNT(j)]); sum += c; cnt += (c > 0u) ? 1u : 0u; mine = (j == x) ? c : mine; }
        if (sum == G) break;
        __builtin_amdgcn_s_sleep(1);
        if ((++sp & 255u) == 0u) { if (xb_ld(&bar[XB_TMO])) break; if (sp > XB_SPIN_CAP) { atomicAdd(&bar[XB_TMO], 1u); break; } }
    }
    nloc = mine > 0u ? mine : 1u; nx = cnt > 0u ? cnt : 1u;
}

__device__ __forceinline__ void xcd_barrier(const XcdBarrier& b) {
    asm volatile("s_waitcnt vmcnt(0)" ::: "memory");
    __syncthreads();
    if (threadIdx.x == 0) {
        unsigned* bar = b.bar;
        __builtin_amdgcn_s_waitcnt(0);
        unsigned nloc = b.st[0], nx = b.st[1];
        if (nloc == 0u) { xcd_barrier_complete(bar, b.x, nloc, nx); b.st[0] = nloc; b.st[1] = nx; }
        const unsigned old = xb_add(&bar[XB_XSUB(b.x)], 1u);
        const unsigned gen = old / nloc;
        if (old + 1u == (gen + 1u) * nloc) {
            __builtin_amdgcn_fence(__ATOMIC_RELEASE, "agent");
            asm volatile("s_waitcnt vmcnt(0)" ::: "memory");
            const unsigned og = xb_add(&bar[XB_TOP], 1u);
            const unsigned tg = og / nx;
            if (og + 1u == (tg + 1u) * nx) xb_add(&bar[XB_TOPGEN], 1u);
            else XB_SPIN(xb_ld(&bar[XB_TOPGEN]) == tg, bar);
            __builtin_amdgcn_fence(__ATOMIC_ACQUIRE, "agent");
            xb_add(&bar[XB_XGEN(b.x)], 1u);
            asm volatile("s_waitcnt vmcnt(0)" ::: "memory");
        } else {
            XB_SPIN(xb_ld(&bar[XB_XGEN(b.x)]) == gen, bar);
            __builtin_amdgcn_fence(__ATOMIC_ACQUIRE, "agent");
            asm volatile("s_waitcnt vmcnt(0)" ::: "memory");
        }
    }
    __syncthreads();
}

struct Args { const void* in[17]; float* out; unsigned char* ws; };

__global__ void __launch_bounds__(NTHR, 2) fwd_megakernel(Args a) {
    extern __shared__ __attribute__((aligned(16))) unsigned char lds[];
    cg::grid_group grid = cg::this_grid();
    LAS unsigned char* ldsl = (LAS unsigned char*)lds;
    const int G = gridDim.x, bx = blockIdx.x;
    const int vcu = (G % 8 == 0) ? (bx % 8) * (G / 8) + bx / 8 : bx;
    const int NGW = G * NWAVES;
    unsigned char* ws = a.ws;
    const float* x_in = (const float*)a.in[0]; const int* positions = (const int*)a.in[1];
    float* LOGF = (float*)(ws + WS_LOGF); float* CNEG = (float*)(ws + WS_CNEG); float* CS = (float*)(ws + WS_CS);
    bf16r* W1t = (bf16r*)(ws + WS_W1); bf16r* Wmgt = (bf16r*)(ws + WS_WMG); bf16r* Wbrt = (bf16r*)(ws + WS_WBR); bf16r* Wot = (bf16r*)(ws + WS_WO);
    bf16r* H = (bf16r*)(ws + WS_H); bf16r* OD = (bf16r*)(ws + WS_OD); bf16r* P = (bf16r*)(ws + WS_P); bf16r* O16 = (bf16r*)(ws + WS_P);
    float* out = a.out;
    volatile LAS unsigned* misc = (volatile LAS unsigned*)(ldsl + LDS_MISC);
    if (threadIdx.x < 64) misc[threadIdx.x] = 0u;
    __syncthreads();
    XcdBarrier xbar = xcd_barrier_post((unsigned*)(ws + WS_CTL), misc);
    bool first_sync = true;
#define GSYNC() do { if (first_sync) { grid.sync(); first_sync = false; } else xcd_barrier(xbar); } while (0)
#ifdef PROBE_K
    unsigned long long ts_prev = __builtin_amdgcn_s_memrealtime(); float ts_acc = 0.f;
#define STAMP(k) do { const unsigned long long t_ = __builtin_amdgcn_s_memrealtime(); if ((k) == PROBE_K) ts_acc += (float)(t_ - ts_prev); \
        if ((k) == 5 && PROBE_K == 6) { GSYNC(); const unsigned long long t2_ = __builtin_amdgcn_s_memrealtime(); ts_acc += (float)(t2_ - t_); ts_prev = t2_; } else ts_prev = t_; } while (0)
#else
#define STAMP(k) do {} while (0)
#endif

#pragma unroll 1
    for (int l = 0; l <= DEPTH; ++l) {
        const bool fin = (l == DEPTH);
        for (int rep_ = 0; rep_ < (fin ? 1 : REP_A); ++rep_) {
        if (!fin && (PHM & 1)) {
            int tid = threadIdx.x; asm volatile("" : "+v"(tid)); const int lane = tid & 63, wave = __builtin_amdgcn_readfirstlane(tid >> 6), gw = bx * NWAVES + wave; (void)lane; (void)gw;
            LAS float* scr = (LAS float*)(ldsl + 32768 + wave * 8704);
            const float* win = (const float*)a.in[3] + (size_t)l * DM * INW;
            const float* wbf = (const float*)a.in[12] + (size_t)l * 512 * DM; const float* wbd = (const float*)a.in[13] + (size_t)l * 512 * DM;
            const float* wbc = (const float*)a.in[14] + (size_t)l * 512 * DM; const float* wo = (const float*)a.in[15] + (size_t)l * DM * DM;
            constexpr int I_1 = 16 * 192, I_G = 16 * 96, I_B = 8 * 32, I_O = 16 * 32, NITEMS = I_1 + I_G + 3 * I_B + I_O;
            for (int repw_ = 0; repw_ < REP_W; ++repw_)
            for (int it = gw; it < NITEMS; it += NGW) {
                int r = it;
                if (r < I_1) { transpose_item<1>(win, INW, DM, PW, W1t, scr, r, lane); continue; } r -= I_1;
                if (r < I_G) { transpose_item<2>(win, INW, DM, NMG, Wmgt, scr, r, lane); continue; } r -= I_G;
                if (r < I_B) { transpose_item<0>(wbf, DM, 512, DM, Wbrt, scr, r, lane); continue; } r -= I_B;
                if (r < I_B) { transpose_item<0>(wbd, DM, 512, DM, Wbrt + 512 * DM, scr, r, lane); continue; } r -= I_B;
                if (r < I_B) { transpose_item<0>(wbc, DM, 512, DM, Wbrt + 2 * 512 * DM, scr, r, lane); continue; } r -= I_B;
                transpose_item<0>(wo, DM, DM, DM, Wot, scr, r, lane);
            }
        }
        if (PHM & 2) {
            int tid = threadIdx.x; asm volatile("" : "+v"(tid)); const int lane = tid & 63, wave = __builtin_amdgcn_readfirstlane(tid >> 6), gw = bx * NWAVES + wave; (void)lane; (void)gw;
            LAS float* wff = (LAS float*)ldsl;
            if (!fin) { const float* win = (const float*)a.in[3] + (size_t)l * DM * INW;
                for (int i = tid; i < 8192; i += NTHR) { const int k = i >> 3, hh = i & 7; wff[hh * 1024 + k] = win[(size_t)k * INW + 1536 + hh]; } }
            __syncthreads();
            const float* xin = (l <= 1) ? x_in : out;
            const f32x4* postg = (const f32x4*)((const float*)a.in[16] + (size_t)(l > 0 ? l - 1 : 0) * DM);
            const f32x4* preg = (const f32x4*)((const float*)a.in[2] + (size_t)(fin ? 0 : l) * DM);
            const float* bfg = (const float*)a.in[4] + (fin ? 0 : l) * 8;
            for (int row0 = gw; row0 < T; row0 += 2 * NGW) {
                f32x4 v[2][4]; int rows[2]; bool ok[2];
#pragma unroll
                for (int q = 0; q < 2; ++q) { rows[q] = row0 + q * NGW; ok[q] = rows[q] < T; if (!ok[q]) rows[q] = row0;
                    const f32x4* xr = (const f32x4*)(xin + (size_t)rows[q] * DM) + lane;
#pragma unroll
                    for (int j = 0; j < 4; ++j) v[q][j] = xr[64 * j]; }
                if (l > 0) {
                    f32x4 ov[2][4]; float ss[2];
#pragma unroll
                    for (int q = 0; q < 2; ++q) { const uint2* orw = (const uint2*)(O16 + (size_t)rows[q] * DM) + lane; ss[q] = 0.f;
#pragma unroll
                        for (int j = 0; j < 4; ++j) { const uint2 w_ = orw[64 * j]; ov[q][j] = (f32x4){pg8::bf_lo(w_.x), pg8::bf_hi(w_.x), pg8::bf_lo(w_.y), pg8::bf_hi(w_.y)}; ss[q] += (ov[q][j].x * ov[q][j].x + ov[q][j].y * ov[q][j].y) + (ov[q][j].z * ov[q][j].z + ov[q][j].w * ov[q][j].w); } }
#pragma unroll
                    for (int o = 1; o < 64; o <<= 1) { ss[0] += __shfl_xor(ss[0], o); ss[1] += __shfl_xor(ss[1], o); }
#pragma unroll
                    for (int q = 0; q < 2; ++q) { const float rs = rsqrtf(ss[q] * (1.f / DM) + RMS_EPS);
                        f32x4* xo = (f32x4*)(out + (size_t)rows[q] * DM) + lane;
#pragma unroll
                        for (int j = 0; j < 4; ++j) { v[q][j] = v[q][j] + ov[q][j] * rs * postg[lane + 64 * j]; if (ok[q]) xo[64 * j] = v[q][j]; } }
                }
                if (!fin) {
                    float ss[2];
#pragma unroll
                    for (int q = 0; q < 2; ++q) { ss[q] = 0.f;
#pragma unroll
                        for (int j = 0; j < 4; ++j) ss[q] += (v[q][j].x * v[q][j].x + v[q][j].y * v[q][j].y) + (v[q][j].z * v[q][j].z + v[q][j].w * v[q][j].w); }
#pragma unroll
                    for (int o = 1; o < 64; o <<= 1) { ss[0] += __shfl_xor(ss[0], o); ss[1] += __shfl_xor(ss[1], o); }
                    float f[2];
#pragma unroll
                    for (int q = 0; q < 2; ++q) { const float rs = rsqrtf(ss[q] * (1.f / DM) + RMS_EPS);
                        unsigned long long* o8 = (unsigned long long*)(H + (size_t)rows[q] * DM) + lane;
#pragma unroll
                        for (int j = 0; j < 4; ++j) { v[q][j] = v[q][j] * rs * preg[lane + 64 * j];
                            if (ok[q]) o8[64 * j] = (unsigned long long)pk2(v[q][j].x, v[q][j].y) | ((unsigned long long)pk2(v[q][j].z, v[q][j].w) << 32); }
                        float d[8];
#pragma unroll
                        for (int hh = 0; hh < 8; ++hh) { float s_ = 0.f;
#pragma unroll
                            for (int j = 0; j < 4; ++j) { const f32x4 w = *(const LAS f32x4*)(wff + hh * 1024 + 4 * lane + 256 * j); s_ += (v[q][j].x * w.x + v[q][j].y * w.y) + (v[q][j].z * w.z + v[q][j].w * w.w); }
                            d[hh] = s_; }
                        float a4[4], c2[2];
                        const bool h5 = (lane & 32) != 0, h4 = (lane & 16) != 0, h3 = (lane & 8) != 0;
#pragma unroll
                        for (int i = 0; i < 4; ++i) { const float keep = h5 ? d[i + 4] : d[i], give = h5 ? d[i] : d[i + 4]; a4[i] = keep + __shfl_xor(give, 32); }
#pragma unroll
                        for (int i = 0; i < 2; ++i) { const float keep = h4 ? a4[i + 2] : a4[i], give = h4 ? a4[i] : a4[i + 2]; c2[i] = keep + __shfl_xor(give, 16); }
                        { const float keep = h3 ? c2[1] : c2[0], give = h3 ? c2[0] : c2[1]; f[q] = keep + __shfl_xor(give, 8); }
                        f[q] += __shfl_xor(f[q], 4); f[q] += __shfl_xor(f[q], 2); f[q] += __shfl_xor(f[q], 1);
                    }
#pragma unroll
                    for (int q = 0; q < 2; ++q) if (ok[q]) {
                        const int i = lane >> 3;
                        if ((lane & 7) == 0) { const float z = f[q] + bfg[i];
                            LOGF[(size_t)rows[q] * 8 + i] = fminf(z, 0.f) - log1pf(expf(-fabsf(z)));
                        } else if (l == 0 && (lane & 7) == 1) {
                            float invf = 1.0f;
                            invf = (i == 1) ? 0.19392274f : invf; invf = (i == 2) ? 0.03760603f : invf; invf = (i == 3) ? 0.0072926646f : invf; invf = (i == 4) ? 0.0014142136f : invf;
                            invf = (i == 5) ? 0.0002742482f : invf; invf = (i == 6) ? 5.3182957e-05f : invf; invf = (i == 7) ? 1.0313385e-05f : invf;
                            const float ang = (float)positions[rows[q]] * invf;
                            const float n = rintf(ang * 0.15915494309189535f);
                            float r = fmaf(-n, 6.2831854820251465f, ang); r = fmaf(-n, -1.7484555e-7f, r);
                            CS[(size_t)rows[q] * 16 + i] = __cosf(r); CS[(size_t)rows[q] * 16 + 8 + i] = __sinf(r);
                        }
                    }
                }
            }
        }
        __syncthreads();
        }
        if (fin) break;
        GSYNC();
        STAMP(0);
        if (PHM & 4) {
            int tid = threadIdx.x; asm volatile("" : "+v"(tid)); const int lane = tid & 63, wave = __builtin_amdgcn_readfirstlane(tid >> 6), gw = bx * NWAVES + wave; (void)lane; (void)gw;
            LAS float* sc = (LAS float*)ldsl;
            for (int bh = bx; bh < NB * 8; bh += G) {
                const int b = bh >> 3, hh = bh & 7; const int t0 = tid * 8;
                float v[8]; float run = 0.f;
#pragma unroll
                for (int e = 0; e < 8; ++e) { run += LOGF[((size_t)b * SEQ + t0 + e) * 8 + hh]; v[e] = run; }
                float incl = run;
#pragma unroll
                for (int o = 1; o < 64; o <<= 1) { const float n = __shfl_up(incl, o); if (lane >= o) incl += n; }
                if (lane == 63) sc[wave] = incl;
                __syncthreads();
                float base = incl - run;
                for (int w = 0; w < wave; ++w) base += sc[w];
                float* cn = CNEG + (size_t)bh * SEQ + t0;
#pragma unroll
                for (int e = 0; e < 8; ++e) cn[e] = -(base + v[e]) * 1.4426950408889634f;
                __syncthreads();
            }
            pg8::Gemm g{H, W1t, DM, DM, 0, 0}; pg8::StaticOrder S; S.init(T, PW, G, bx, WGM_B);
            pg8::EpiProj E{P, CS};
            for (int rep_ = 0; rep_ < REP_B; ++rep_) pg8::gemm_phase<pg8::EpiProj, pg8::StaticOrder, true, true>(ldsl, g, S, E);
        }
        GSYNC();
        STAMP(1);
        if (PHM & 8) {
            int tid = threadIdx.x; asm volatile("" : "+v"(tid)); const int lane = tid & 63, wave = __builtin_amdgcn_readfirstlane(tid >> 6), gw = bx * NWAVES + wave; (void)lane; (void)gw;
            const float* cw = (const float*)a.in[6] + (size_t)l * 3 * 512;
            for (int repx_ = (l == 0 ? REP_X : 1) - 1; repx_ >= 0; --repx_)
#pragma unroll 2
            for (int it = bx * NTHR + tid; it < T * 64; it += G * NTHR) {
                const int t = it >> 6, c8 = (it & 63) * 8, s = t & (SEQ - 1);
                bf16r* pr = P + (size_t)t * PW;
                const v4u cb = *(const v4u*)(pr + 4096 + c8), cg_ = *(const v4u*)(pr + 5632 + c8);
                const v4u zero = (v4u){0u, 0u, 0u, 0u};
                const v4u c0 = *(const v4u*)(pr + 4608 + c8), x0 = *(const v4u*)(pr + 5120 + c8);
                const v4u c1 = s >= 1 ? *(const v4u*)(pr - PW + 4608 + c8) : zero, x1 = s >= 1 ? *(const v4u*)(pr - PW + 5120 + c8) : zero;
                const v4u c2 = s >= 2 ? *(const v4u*)(pr - 2 * PW + 4608 + c8) : zero, x2 = s >= 2 ? *(const v4u*)(pr - 2 * PW + 5120 + c8) : zero;
                float k0[8], k1[8], k2[8];
#pragma unroll
                for (int q = 0; q < 2; ++q) { const f32x4 wa = *(const f32x4*)(cw + c8 + 4 * q), wb = *(const f32x4*)(cw + 512 + c8 + 4 * q), wc_ = *(const f32x4*)(cw + 1024 + c8 + 4 * q);
                    k0[4 * q] = wa.x; k0[4 * q + 1] = wa.y; k0[4 * q + 2] = wa.z; k0[4 * q + 3] = wa.w; k1[4 * q] = wb.x; k1[4 * q + 1] = wb.y; k1[4 * q + 2] = wb.z; k1[4 * q + 3] = wb.w;
                    k2[4 * q] = wc_.x; k2[4 * q + 1] = wc_.y; k2[4 * q + 2] = wc_.z; k2[4 * q + 3] = wc_.w; }
                v4u o;
#pragma unroll
                for (int e = 0; e < 4; ++e) {
                    const float ul0 = pg8::bf_lo(c0[e]) * pg8::bf_lo(x0[e]), uh0 = pg8::bf_hi(c0[e]) * pg8::bf_hi(x0[e]);
                    const float ul1 = pg8::bf_lo(c1[e]) * pg8::bf_lo(x1[e]), uh1 = pg8::bf_hi(c1[e]) * pg8::bf_hi(x1[e]);
                    const float ul2 = pg8::bf_lo(c2[e]) * pg8::bf_lo(x2[e]), uh2 = pg8::bf_hi(c2[e]) * pg8::bf_hi(x2[e]);
                    const float yl = pg8::bf_lo(cb[e]) * (k0[2 * e] * ul2 + k1[2 * e] * ul1 + k2[2 * e] * ul0) * silu_f(pg8::bf_lo(cg_[e]));
                    const float yh = pg8::bf_hi(cb[e]) * (k0[2 * e + 1] * uh2 + k1[2 * e + 1] * uh1 + k2[2 * e + 1] * uh0) * silu_f(pg8::bf_hi(cg_[e]));
                    o[e] = pk2(yl, yh);
                }
                if (repx_ > 0) *(v4u*)((bf16r*)out + (size_t)t * 512 + c8) = o; else *(v4u*)(pr + 4096 + c8) = o;
            }
            asm volatile("s_waitcnt vmcnt(0)" ::: "memory"); __syncthreads();
            const int NPAIR = NB * 16 * 8, PPW = (NPAIR + G - 1) / G;
            for (int rep_ = (l == 0 ? REP_C : 1) - 1; rep_ >= 0; --rep_)
            for (int pj = 0; pj < PPW; ++pj) {
                int b, u, s;
                if (G == 256) { const int j = vcu >> 5, w = vcu & 31; b = j >> 1; u = pj * 8 + (j & 1) * 4 + (w >> 3); s = w & 7; }
                else { const int pi = vcu * PPW + pj; if (pi >= NPAIR) break; const int bhu = pi >> 3; s = pi & 7; b = bhu >> 4; u = bhu & 15; }
                const attn_body::bf16* Pb = (const attn_body::bf16*)(P + (size_t)b * SEQ * PW);
                if (u < 8) {
                    const attn_body::bf16 *Qp = Pb + u * 64, *Kp = Pb + 512 + u * 64, *Vp = Pb + 1024 + u * 64; attn_body::bf16* Op = (attn_body::bf16*)Qp; int ldo = PW;
                    const float* bias = CNEG + (size_t)(b * 8 + u) * SEQ;
                    if (rep_ > 0) { Op = (attn_body::bf16*)out + (size_t)b * SEQ * 512 + u * 64; ldo = 512; }
#pragma unroll 1
                    for (int k = 0; k < 2; ++k) attn_body::attn_unit<8, true, false>(k ? 15 - s : s, Qp, Kp, Vp, Op, PW, ldo, bias, Pb + 1536 + u * 64, (char*)lds);
                } else {
                    const int d = u - 8, h = d >> 1, c = d & 1;
                    const attn_body::bf16 *Qp = Pb + 2048 + h * 128 + c * 64, *Kp = Pb + 2560 + h * 128 + c * 64, *Vp = Pb + 3072 + h * 128;
                    attn_body::bf16* Op = (attn_body::bf16*)(OD + (size_t)b * SEQ * DM) + c * 512 + h * 128;
#pragma unroll 1
                    for (int k = 0; k < 2; ++k) attn_body::attn_unit<8, false, true>(k ? 15 - s : s, Qp, Kp, Vp, Op, PW, DM, nullptr, nullptr, (char*)lds);
                }
            }
        }
        GSYNC();
        STAMP(2);
        if (PHM & 16) {
            int tid = threadIdx.x; asm volatile("" : "+v"(tid)); const int lane = tid & 63, wave = __builtin_amdgcn_readfirstlane(tid >> 6), gw = bx * NWAVES + wave; (void)lane; (void)gw;
            for (int repy_ = (l == 0 ? REP_Y : 1) - 1; repy_ >= 0; --repy_) {
            const float lam_init = 0.8f - 0.6f * expf(-0.3f * (float)l);
            const float p1 = ((const float*)a.in[7])[l * 64 + lane] * ((const float*)a.in[8])[l * 64 + lane], p2 = ((const float*)a.in[9])[l * 64 + lane] * ((const float*)a.in[10])[l * 64 + lane];
            const float lam = expf(wave_sum(p1)) - expf(wave_sum(p2)) + lam_init;
            const float* dgn = (const float*)a.in[11] + (size_t)l * 128;
            const int j0 = (lane & 15) * 8;
            const f32x4 ga = *(const f32x4*)(dgn + j0), gb = *(const f32x4*)(dgn + j0 + 4); const float gg[8] = {ga.x, ga.y, ga.z, ga.w, gb.x, gb.y, gb.z, gb.w};
#pragma unroll 4
            for (int it = gw; it < T; it += NGW) {
                const int t = it, h = lane >> 4; bf16r* pr = P + (size_t)t * PW; const bf16r* od = OD + (size_t)t * DM;
                const v4u o0 = *(const v4u*)(od + h * 128 + j0), o1 = *(const v4u*)(od + 512 + h * 128 + j0), dg = *(const v4u*)(pr + 3584 + h * 128 + j0);
                float dv[8]; float ss = 0.f;
#pragma unroll
                for (int e = 0; e < 4; ++e) { dv[2 * e] = pg8::bf_lo(o0[e]) - lam * pg8::bf_lo(o1[e]); dv[2 * e + 1] = pg8::bf_hi(o0[e]) - lam * pg8::bf_hi(o1[e]); ss += dv[2 * e] * dv[2 * e] + dv[2 * e + 1] * dv[2 * e + 1]; }
                ss += __shfl_xor(ss, 1); ss += __shfl_xor(ss, 2); ss += __shfl_xor(ss, 4); ss += __shfl_xor(ss, 8);
                const float rs = rsqrtf(ss * (1.f / 128.f) + RMS_EPS) * (1.f - lam_init);
                v4u o;
#pragma unroll
                for (int e = 0; e < 4; ++e) { const float g0 = gg[2 * e], g1 = gg[2 * e + 1];
                    o[e] = pk2(dv[2 * e] * rs * g0 * silu_f(pg8::bf_lo(dg[e])), dv[2 * e + 1] * rs * g1 * silu_f(pg8::bf_hi(dg[e]))); }
                if (repy_ > 0) *(v4u*)((bf16r*)out + (size_t)T * 512 + (size_t)t * 512 + h * 128 + j0) = o; else *(v4u*)(pr + 2048 + h * 128 + j0) = o;
            }
            }
            asm volatile("s_waitcnt vmcnt(0)" ::: "memory"); __syncthreads();
            pg8::Gemm g{H, Wmgt, DM, DM, 0, 0}; pg8::StaticOrder S; S.init(T, NMG, G, bx, WGM_G);
            pg8::EpiGate E{P, (const float*)a.in[5] + (size_t)l * NMG};
            for (int rep_ = 0; rep_ < REP_G; ++rep_) pg8::gemm_phase<pg8::EpiGate, pg8::StaticOrder, true, true>(ldsl, g, S, E);
        }
        GSYNC();
        STAMP(3);
        if (PHM & 32) {
            pg8::Gemm g{P, Wbrt, PW, 512, 2048, (size_t)512 * DM}; pg8::MergeOrder S; S.init(T, DM, G, bx);
            pg8::EpiMerge E{P, H};
            for (int rep_ = 0; rep_ < REP_D; ++rep_) pg8::gemm_phase<pg8::EpiMerge, pg8::MergeOrder, true, true>(ldsl, g, S, E);
        }
        GSYNC();
        STAMP(4);
        if (PHM & 64) {
            pg8::Gemm g{H, Wot, DM, DM, 0, 0}; pg8::StaticOrder S; S.init(T, DM, G, bx);
            pg8::EpiF32 E{O16};
            for (int rep_ = 0; rep_ < REP_E; ++rep_) pg8::gemm_phase<pg8::EpiF32, pg8::StaticOrder, true, true>(ldsl, g, S, E);
        }
        GSYNC();
        for (int rep_ = 0; rep_ < REP_S; ++rep_) GSYNC();
        STAMP(5);
    }
#ifdef PROBE_K
    GSYNC();
    if (bx == 0 && threadIdx.x == 0) out[0] = ts_acc * 0.1f;
#endif
#undef GSYNC
}

extern "C" void kernel_launch(void* const* d_in, const int* in_sizes, int n_in, void* d_out, int out_size, void* d_ws, size_t ws_size, hipStream_t stream) {
    static int grid = 0;
    if (grid == 0) {
        if (n_in != 17 || out_size != T * DM || ws_size < WS_END) { fprintf(stderr, "kernel_launch: unexpected shapes / workspace (n_in %d, out %d, ws %zu < %zu)\n", n_in, out_size, ws_size, (size_t)WS_END); grid = -1; return; }
        int dev = 0, cus = 0, per_cu = 0;
        hipGetDevice(&dev); hipDeviceGetAttribute(&cus, hipDeviceAttributeMultiprocessorCount, dev);
        hipFuncSetAttribute((const void*)fwd_megakernel, hipFuncAttributeMaxDynamicSharedMemorySize, LDS_BYTES);
        if (hipOccupancyMaxActiveBlocksPerMultiprocessor(&per_cu, (const void*)fwd_megakernel, NTHR, LDS_BYTES) != hipSuccess || per_cu < 1) per_cu = 1;
        (void)hipGetLastError();
        grid = cus * per_cu;
    }
    if (grid < 0) return;
    (void)hipMemsetAsync((char*)d_ws + WS_CTL, 0, CTL_BYTES, stream);
    Args a{};
    for (int i = 0; i < 17; ++i) a.in[i] = d_in[i];
    a.out = (float*)d_out; a.ws = (unsigned char*)d_ws;
    void* args[] = {&a};
    hipError_t e = hipLaunchCooperativeKernel((const void*)fwd_megakernel, dim3(grid), dim3(NTHR), args, LDS_BYTES, stream);
    if (e != hipSuccess) fprintf(stderr, "cooperative launch failed: %s (grid %d)\n", hipGetErrorString(e), grid);
}
```
